# Optimizing an MI355X kernel written in HIP

```python
import math
import jax, jax.numpy as jnp
from jax import lax
import numpy as np


D_MODEL = 1024
BATCH = 8
SEQ = 8192
DEPTH = 2

ATTN_HEADS = 8
ATTN_KV_GROUPS = 2
HEAD_DIM = 64
IDX_HEADS = 4
IDX_DIM = 64
TOPK_MAX = 256
Q_BLOCK = 128
NUM_BUCKETS = 32
MAX_DISTANCE = 128
HGRN_HEADS = 4
HGRN_DIM = 128
HGRN_CHUNK = 64
CONV_W = 512
CONV_K = 3
D_FF = 4 * D_MODEL

ATTN_W = ATTN_HEADS * HEAD_DIM
KV_W = ATTN_KV_GROUPS * HEAD_DIM
HGRN_W = HGRN_HEADS * HGRN_DIM
N_BRANCH = 3
EPS = 1e-6
SPLITS = (ATTN_W, KV_W, KV_W,
          IDX_HEADS * IDX_DIM, IDX_DIM, IDX_HEADS,
          HGRN_W, HGRN_W, HGRN_W, HGRN_W,
          CONV_W, CONV_W, CONV_W,
          N_BRANCH * D_MODEL)
D_IN_PROJ = sum(SPLITS)

kernel_name = "hybrid_dsa_hgrn2_shortconv_block"


def _rmsnorm(x, g):
    xf = x.astype(jnp.float32)
    y = xf * lax.rsqrt(jnp.mean(xf * xf, axis=-1, keepdims=True) + EPS)
    return (y * g.astype(jnp.float32)).astype(x.dtype)


def _split_cols(p):
    offs, acc = [], 0
    for w in SPLITS[:-1]:
        acc += w
        offs.append(acc)
    return jnp.split(p, offs, axis=-1)


def _t5_bucket(dist):
    max_exact = NUM_BUCKETS // 2
    d = jnp.maximum(dist, 0)
    df = jnp.maximum(d, 1).astype(jnp.float32)
    large = max_exact + (jnp.log(df / max_exact) / math.log(MAX_DISTANCE / max_exact)
                         * (NUM_BUCKETS - max_exact)).astype(jnp.int32)
    large = jnp.minimum(large, NUM_BUCKETS - 1)
    return jnp.where(d < max_exact, d, large)


def _dsa_attention(q, k, v, qi, ki, wi, rel_bias):
    b, s = q.shape[0], q.shape[1]
    n_sel = min(TOPK_MAX, s // 4)
    nb = s // Q_BLOCK
    npg = ATTN_HEADS // ATTN_KV_GROUPS
    scale = HEAD_DIM ** -0.5
    wi = wi * (IDX_HEADS ** -0.5 * IDX_DIM ** -0.5)
    key_pos = jnp.arange(s)
    bidx = jnp.arange(b)[:, None, None]

    def blocks(a):
        return jnp.moveaxis(a.reshape((b, nb, Q_BLOCK) + a.shape[2:]), 1, 0)

    def one_block(args):
        blk, q_b, qi_b, wi_b = args
        t = blk * Q_BLOCK + jnp.arange(Q_BLOCK)
        sc = jax.nn.relu(jnp.einsum('bqhd,bsd->bqhs', qi_b, ki))
        sc = jnp.einsum('bqhs,bqh->bqs', sc, wi_b).astype(jnp.float32)
        causal = key_pos[None, :] <= t[:, None]
        sc = jnp.where(causal[None], sc, -jnp.inf)
        _, idx = lax.top_k(sc, n_sel)
        valid = idx <= t[None, :, None]
        k_sel = k[bidx, idx]
        v_sel = v[bidx, idx]
        qg = q_b.reshape(b, Q_BLOCK, ATTN_KV_GROUPS, npg, HEAD_DIM)
        logits = jnp.einsum('bqgnd,bqkgd->bqgnk', qg, k_sel).astype(jnp.float32) * scale
        bias = rel_bias[_t5_bucket(t[None, :, None] - idx)]
        bias = jnp.moveaxis(bias, -1, 2).reshape(b, Q_BLOCK, ATTN_KV_GROUPS, npg, n_sel)
        logits = jnp.where(valid[:, :, None, None, :], logits + bias.astype(jnp.float32), -jnp.inf)
        p = jax.nn.softmax(logits, axis=-1).astype(v.dtype)
        o = jnp.einsum('bqgnk,bqkgd->bqgnd', p, v_sel)
        return o.reshape(b, Q_BLOCK, ATTN_W)

    out = lax.map(one_block, (jnp.arange(nb), blocks(q), blocks(qi), blocks(wi)))
    return jnp.moveaxis(out, 0, 1).reshape(b, s, ATTN_W)


def _hgrn2(q, f_logit, i, lb):
    b, s = q.shape[0], q.shape[1]
    nc = s // HGRN_CHUNK
    f32 = jnp.float32
    z = f_logit.astype(f32)
    lb = lb.astype(f32).reshape(HGRN_HEADS, HGRN_DIM)
    log_f = jnp.logaddexp(jnp.log(lb), jnp.log1p(-lb) + jax.nn.log_sigmoid(z))
    kk = (1.0 - lb) * jax.nn.sigmoid(-z)

    def chunks(a):
        return a.reshape(b, nc, HGRN_CHUNK, HGRN_HEADS, HGRN_DIM).transpose(1, 0, 3, 2, 4)

    tri = jnp.tril(jnp.ones((HGRN_CHUNK, HGRN_CHUNK), dtype=bool))

    def step(state, inp):
        qc, kc, ic, gc = inp
        G = jnp.cumsum(gc, axis=2)
        diff = G[:, :, :, None, :] - G[:, :, None, :, :]
        decay = jnp.exp(jnp.where(tri[:, :, None], diff, -jnp.inf))
        attn = jnp.einsum('bhtd,bhsd,bhtsd->bhts', qc, kc, decay)
        o = attn @ ic + jnp.einsum('bhtd,bhdv->bhtv', qc * jnp.exp(G), state)
        g_last = G[:, :, -1:, :]
        state = (jnp.exp(g_last[:, :, 0, :, None]) * state
                 + jnp.einsum('bhsd,bhsv->bhdv', kc * jnp.exp(g_last - G), ic))
        return state, o

    s0 = jnp.zeros((b, HGRN_HEADS, HGRN_DIM, HGRN_DIM), f32)
    _, o = lax.scan(step, s0, (chunks(q.astype(f32)), chunks(kk), chunks(i.astype(f32)), chunks(log_f)))
    return o.transpose(1, 0, 3, 2, 4).reshape(b, s, HGRN_HEADS, HGRN_DIM)


def _short_conv(u, w):
    kern = w[:, None, :].astype(u.dtype)
    return lax.conv_general_dilated(u, kern, (1,), [(CONV_K - 1, 0)],
                                    dimension_numbers=('NWC', 'WIO', 'NWC'),
                                    feature_group_count=u.shape[-1])


def setup_inputs(seed: int = 0) -> dict:
    key = jax.random.key(seed)
    ks = jax.random.split(key, 16)
    f32 = jnp.float32

    def nrm(k, shape, scale):
        return jax.random.normal(k, shape, f32) * scale

    def gain(k, shape):
        return 1.0 + 0.02 * jax.random.normal(k, shape, f32)

    return {
        'x': nrm(ks[0], (BATCH, SEQ, D_MODEL), 1.0),
        'rel_bias': nrm(ks[1], (NUM_BUCKETS, ATTN_HEADS), 0.5),
        'hgrn_lb': nrm(ks[2], (DEPTH, HGRN_W), 1.0),
        'ln_mix_g': gain(ks[3], (DEPTH, D_MODEL)),
        'w_in': nrm(ks[4], (DEPTH, D_MODEL, D_IN_PROJ), D_MODEL ** -0.5),
        'q_norm_g': gain(ks[5], (DEPTH, HEAD_DIM)),
        'k_norm_g': gain(ks[6], (DEPTH, HEAD_DIM)),
        'hgrn_norm_g': gain(ks[7], (DEPTH, HGRN_DIM)),
        'conv_w': nrm(ks[8], (DEPTH, CONV_K, CONV_W), CONV_K ** -0.5),
        'w_up_attn': nrm(ks[9], (DEPTH, ATTN_W, D_MODEL), ATTN_W ** -0.5),
        'w_up_hgrn': nrm(ks[10], (DEPTH, HGRN_W, D_MODEL), HGRN_W ** -0.5),
        'w_up_conv': nrm(ks[11], (DEPTH, CONV_W, D_MODEL), CONV_W ** -0.5),
        'w_out': nrm(ks[12], (DEPTH, D_MODEL, D_MODEL), D_MODEL ** -0.5),
        'ln_mlp_g': gain(ks[13], (DEPTH, D_MODEL)),
        'w_mlp_up': nrm(ks[14], (DEPTH, D_MODEL, D_FF), D_MODEL ** -0.5),
        'w_mlp_down': nrm(ks[15], (DEPTH, D_FF, D_MODEL), D_FF ** -0.5),
    }


def reference(x, rel_bias, hgrn_lb, ln_mix_g, w_in, q_norm_g, k_norm_g, hgrn_norm_g,
              conv_w, w_up_attn, w_up_hgrn, w_up_conv, w_out, ln_mlp_g, w_mlp_up, w_mlp_down):
    b, s, _ = x.shape
    lb_all = jnp.cumsum(jax.nn.softmax(hgrn_lb.astype(jnp.float32), axis=0), axis=0)
    lb_all = lb_all - lb_all[0]
    for l in range(DEPTH):
        h = _rmsnorm(x, ln_mix_g[l])
        proj = h @ w_in[l]
        (aq, ak, av, iq, ik, iw, hq, hf, hi, hg, cb, cc, ch, gates) = _split_cols(proj)
        q = _rmsnorm(aq.reshape(b, s, ATTN_HEADS, HEAD_DIM), q_norm_g[l])
        k = _rmsnorm(ak.reshape(b, s, ATTN_KV_GROUPS, HEAD_DIM), k_norm_g[l])
        v = av.reshape(b, s, ATTN_KV_GROUPS, HEAD_DIM)
        y_attn = _dsa_attention(q, k, v, iq.reshape(b, s, IDX_HEADS, IDX_DIM), ik, iw, rel_bias)
        o = _hgrn2(hq.reshape(b, s, HGRN_HEADS, HGRN_DIM), hf.reshape(b, s, HGRN_HEADS, HGRN_DIM),
                   hi.reshape(b, s, HGRN_HEADS, HGRN_DIM), lb_all[l])
        y_hgrn = (_rmsnorm(o, hgrn_norm_g[l]).astype(x.dtype)
                  * jax.nn.silu(hg.reshape(b, s, HGRN_HEADS, HGRN_DIM))).reshape(b, s, HGRN_W)
        y_conv = cb * _short_conv(cc * ch, conv_w[l])
        g = jax.nn.sigmoid(gates.reshape(b, s, N_BRANCH, D_MODEL))
        mixed = (g[:, :, 0] * (y_attn @ w_up_attn[l])
                 + g[:, :, 1] * (y_hgrn @ w_up_hgrn[l])
                 + g[:, :, 2] * (y_conv @ w_up_conv[l]))
        x = x + mixed @ w_out[l]
        h = _rmsnorm(x, ln_mlp_g[l])
        x = x + jnp.square(jax.nn.relu(h @ w_mlp_up[l])) @ w_mlp_down[l]
    return x
```

```cpp
#include <hip/hip_runtime.h>
#include <cstdio>
#include <cstdint>
#define ONE_LAUNCH 1
namespace pg8 {
#define PG8_LAS __attribute__((address_space(3)))
typedef unsigned short bf16_t;
typedef short bf16x8 __attribute__((ext_vector_type(8)));
typedef float f32x4 __attribute__((ext_vector_type(4)));
typedef unsigned u32x4 __attribute__((ext_vector_type(4)));
constexpr int BM = 256, BK = 64, HALF = 128, HTB = HALF * BK * 2  , STAGE_BYTES = 8 * HTB, NXCD = 8, WGM = 8;

__host__ __device__ __forceinline__ int lds_byte(int r, int c) { const int st = (r >> 4) * 2 + (c >> 5), rr = r & 15, cc = c & 31, ob = rr * 64 + cc * 2; return st * 1024 + (ob ^ (((ob >> 9) & 1) << 5)); }
__host__ __device__ __forceinline__ void stage_rc(int b, int& R, int& C) { const int st = b / 1024, sb = b % 1024, swz = sb ^ (((sb >> 9) & 1) << 5); R = (st >> 1) * 16 + swz / 64; C = (st & 1) * 32 + (swz % 64) / 2; }
__host__ __device__ __forceinline__ int perm32(int rho) { const int n = rho >> 4, i = rho & 15; return 8 * (i >> 2) + 4 * n + (i & 3); }

struct Unit { int pm, pn; };
struct Gemm { const bf16_t* A; const bf16_t* Bt; int M, N, K; };

struct StaticOrder {
    int nM, nN, nwg, G, c;
    __host__ __device__ void init(int M, int N, int G_, int c_) { nM = M / BM; nN = N / BM; nwg = nM * nN; G = G_; c = c_; }
    __host__ __device__ bool next(int i, Unit& u) const {
        const long L = (long)i * G + c; if (L >= nwg) return false;
        int wgid = (int)L; { const int q = nwg / NXCD, r = nwg % NXCD, xcd = wgid % NXCD, off = wgid / NXCD; wgid = (xcd < r ? xcd * (q + 1) : r * (q + 1) + (xcd - r) * q) + off; }
        const int nig = WGM * nN, gid = wgid / nig, fm = gid * WGM, gsz = (nM - fm) < WGM ? (nM - fm) : WGM;
        u.pm = fm + ((wgid % nig) % gsz); u.pn = (wgid % nig) / gsz; return true;
    }
    __device__ __forceinline__ void a_ready(const Unit&) const {}
    __device__ __forceinline__ void done(const Unit&) const {}
};
__device__ __forceinline__ unsigned cvt_pk_bf16(float lo, float hi) { unsigned r; asm volatile("v_cvt_pk_bf16_f32 %0, %1, %2" : "=v"(r) : "v"(lo), "v"(hi)); return r; }
typedef float f32x2 __attribute__((ext_vector_type(2)));
template <class Epi, class Sched, bool ALIGN_EPI = false, bool SP2 = false>
__device__ __forceinline__ void gemm_phase(PG8_LAS unsigned char* lds, const Gemm g, const Sched& S, const Epi& E, int tid_in) {
    int tid_l = tid_in; asm volatile("" : "+v"(tid_l));
    const int tid = tid_l, wid = __builtin_amdgcn_readfirstlane(tid >> 6), lane = tid & 63, wr = wid >> 2, wc = wid & 3, fr = lane & 15, fq = lane >> 4;
    const int K = g.K, nt = K / BK;
    unsigned voffA[2], voffB[2];
#pragma unroll
    for (int i = 0; i < 2; ++i) { int R, C; stage_rc(tid * 16 + i * 8192, R, C); const int Rb = Epi::PERM ? ((R & ~31) + perm32(R & 31)) : R;
        voffA[i] = (unsigned)(R * K + C) * 2u; voffB[i] = (unsigned)(Rb * K + C) * 2u; }
    const size_t kstep = (size_t)(BK * 2);
    const size_t hstep = (size_t)HALF * K * 2;
    const size_t tstep = 2 * hstep;
    const unsigned ldsw = (unsigned)wid * 1024u;
    const int aoff = lds_byte(wr * 64 + fr, fq * 8), boff = lds_byte(wc * 32 + fr, fq * 8);
#define PG8_SA(b, h) (((b) * 2 + (h)) * HTB)
#define PG8_SB(b, h) ((4 + (b) * 2 + (h)) * HTB)
#define PG8_STAGE(bufoff, gbase, voff) do { _Pragma("unroll") for (int _i = 0; _i < 2; ++_i) \
        __builtin_amdgcn_global_load_lds((const unsigned*)((const char*)(gbase) + (voff)[_i]), (PG8_LAS unsigned*)(lds + (bufoff) + ldsw + _i * 8192), 16, 0, 0); } while (0)
#define PG8_LDA(dst, b, h) do { _Pragma("unroll") for (int m = 0; m < 4; ++m) _Pragma("unroll") for (int k = 0; k < 2; ++k) dst[m][k] = *(const PG8_LAS bf16x8*)(lds + PG8_SA(b, h) + aoff + m * 2048 + k * 1024); } while (0)
#define PG8_LDB(dst, b, h) do { _Pragma("unroll") for (int n = 0; n < 2; ++n) _Pragma("unroll") for (int k = 0; k < 2; ++k) dst[n][k] = *(const PG8_LAS bf16x8*)(lds + PG8_SB(b, h) + boff + n * 2048 + k * 1024); } while (0)
#define PG8_MMA(ai, bj, At, Bt) do { __builtin_amdgcn_s_setprio(1); _Pragma("unroll") for (int m = 0; m < 4; ++m) _Pragma("unroll") for (int n = 0; n < 2; ++n) _Pragma("unroll") for (int k = 0; k < 2; ++k) \
        acc[ai][bj][m][n] = __builtin_amdgcn_mfma_f32_16x16x32_bf16(Bt[n][k], At[m][k], acc[ai][bj][m][n], 0, 0, 0); __builtin_amdgcn_s_setprio(0); } while (0)
#define PG8_WAIT_V(n) asm volatile("s_waitcnt vmcnt(" #n ")" ::: "memory")
#define PG8_WAIT_L(n) asm volatile("s_waitcnt lgkmcnt(" #n ")" ::: "memory")
#define PG8_BAR __builtin_amdgcn_s_barrier()
#define PG8_SCHED __builtin_amdgcn_sched_barrier(0)
    Unit cur, nxt; int ui = 0;
    if (!S.next(0, cur)) return;
    f32x4 acc[2][2][4][2];
#pragma unroll
    for (int a = 0; a < 2; ++a)
#pragma unroll
        for (int b = 0; b < 2; ++b)
#pragma unroll
            for (int m = 0; m < 4; ++m)
#pragma unroll
                for (int n = 0; n < 2; ++n) acc[a][b][m][n] = (f32x4){0.f, 0.f, 0.f, 0.f};
    bf16x8 At[4][2], B0[2][2], B1[2][2];
    const char* cA = (const char*)g.A + (size_t)cur.pm * tstep; const char* cB = (const char*)g.Bt + (size_t)cur.pn * tstep;
    S.a_ready(cur);
    if constexpr (SP2) {
        PG8_STAGE(PG8_SB(0, 0), cB, voffB); PG8_STAGE(PG8_SB(0, 1), cB + hstep, voffB); PG8_STAGE(PG8_SA(0, 0), cA, voffA); PG8_STAGE(PG8_SA(0, 1), cA + hstep, voffA);
        if (wr == 1) PG8_BAR;
        PG8_WAIT_V(2); PG8_BAR;
        PG8_STAGE(PG8_SB(1, 0), cB + kstep, voffB); PG8_STAGE(PG8_SA(1, 0), cA + kstep, voffA); PG8_STAGE(PG8_SB(1, 1), cB + hstep + kstep, voffB);
        PG8_WAIT_V(6); PG8_BAR;
    } else {
        PG8_STAGE(PG8_SB(0, 0), cB, voffB); PG8_STAGE(PG8_SA(0, 0), cA, voffA); PG8_STAGE(PG8_SB(0, 1), cB + hstep, voffB); PG8_STAGE(PG8_SA(0, 1), cA + hstep, voffA);
        if (wr == 1) PG8_BAR;
        PG8_WAIT_V(4); PG8_BAR;
        PG8_STAGE(PG8_SB(1, 0), cB + kstep, voffB); PG8_STAGE(PG8_SA(1, 0), cA + kstep, voffA); PG8_STAGE(PG8_SB(1, 1), cB + hstep + kstep, voffB);
        PG8_WAIT_V(6); PG8_BAR;
    }
    for (;;) {
        const bool has_next = S.next(ui + 1, nxt);
        const char* nA = has_next ? (const char*)g.A + (size_t)nxt.pm * tstep : cA; const char* nB = has_next ? (const char*)g.Bt + (size_t)nxt.pn * tstep : cB;
        for (int t = 0; t < nt; t += 2) {
            const bool last = (t == nt - 2);
            const char* a1 = cA + (size_t)(t + 1) * kstep;
            const char* a2 = last ? nA : cA + (size_t)(t + 2) * kstep; const char* b2 = last ? nB : cB + (size_t)(t + 2) * kstep;
            const char* a3 = a2 + kstep; const char* b3 = b2 + kstep;
            if (last && has_next) S.a_ready(nxt);
            if constexpr (SP2) {
            PG8_LDB(B0, 0, 0); PG8_LDB(B1, 0, 1); PG8_SCHED; PG8_LDA(At, 0, 0); PG8_STAGE(PG8_SA(1, 1), a1 + hstep, voffA);
            PG8_WAIT_V(8); PG8_WAIT_L(0); PG8_BAR; PG8_MMA(0, 0, At, B0); PG8_MMA(0, 1, At, B1); PG8_BAR; PG8_SCHED;
            PG8_LDA(At, 0, 1); PG8_STAGE(PG8_SB(0, 0), b2, voffB); PG8_STAGE(PG8_SB(0, 1), b2 + hstep, voffB); PG8_STAGE(PG8_SA(0, 0), a2, voffA);
            PG8_WAIT_V(8); PG8_WAIT_L(0); PG8_BAR; PG8_MMA(1, 0, At, B0); PG8_MMA(1, 1, At, B1); PG8_BAR; PG8_SCHED;
            PG8_LDB(B0, 1, 0); PG8_LDB(B1, 1, 1); PG8_SCHED; PG8_LDA(At, 1, 0); PG8_STAGE(PG8_SA(0, 1), a2 + hstep, voffA);
            PG8_WAIT_V(8); PG8_WAIT_L(0); PG8_BAR; PG8_MMA(0, 0, At, B0); PG8_MMA(0, 1, At, B1); PG8_BAR; PG8_SCHED;
            PG8_LDA(At, 1, 1); PG8_STAGE(PG8_SB(1, 0), b3, voffB); PG8_STAGE(PG8_SB(1, 1), b3 + hstep, voffB); PG8_STAGE(PG8_SA(1, 0), a3, voffA);
            PG8_WAIT_V(8); PG8_WAIT_L(0); PG8_BAR; PG8_MMA(1, 0, At, B0); PG8_MMA(1, 1, At, B1); PG8_BAR; PG8_SCHED;
            } else {
            PG8_LDB(B0, 0, 0); PG8_SCHED; PG8_LDA(At, 0, 0); PG8_STAGE(PG8_SA(1, 1), a1 + hstep, voffA);
            PG8_WAIT_L(8); PG8_BAR; PG8_WAIT_L(0); PG8_MMA(0, 0, At, B0); PG8_BAR; PG8_SCHED;
            PG8_LDB(B1, 0, 1); PG8_STAGE(PG8_SB(0, 0), b2, voffB);
            PG8_BAR; PG8_WAIT_L(0); PG8_MMA(0, 1, At, B1); PG8_BAR;
            PG8_LDA(At, 0, 1); PG8_STAGE(PG8_SA(0, 0), a2, voffA);
            PG8_BAR; PG8_WAIT_L(0); PG8_MMA(1, 0, At, B0); PG8_BAR; PG8_SCHED;
            PG8_STAGE(PG8_SB(0, 1), b2 + hstep, voffB);
            PG8_WAIT_V(6); PG8_BAR; PG8_MMA(1, 1, At, B1); PG8_BAR;
            PG8_LDB(B0, 1, 0); PG8_SCHED; PG8_LDA(At, 1, 0); PG8_STAGE(PG8_SA(0, 1), a2 + hstep, voffA);
            PG8_WAIT_L(8); PG8_BAR; PG8_WAIT_L(0); PG8_MMA(0, 0, At, B0); PG8_BAR; PG8_SCHED;
            PG8_LDB(B1, 1, 1); PG8_STAGE(PG8_SB(1, 0), b3, voffB);
            PG8_BAR; PG8_WAIT_L(0); PG8_MMA(0, 1, At, B1); PG8_BAR;
            PG8_LDA(At, 1, 1); PG8_STAGE(PG8_SA(1, 0), a3, voffA);
            PG8_BAR; PG8_WAIT_L(0); PG8_MMA(1, 0, At, B0); PG8_BAR; PG8_SCHED;
            PG8_STAGE(PG8_SB(1, 1), b3 + hstep, voffB);
            PG8_WAIT_V(6); PG8_BAR; PG8_MMA(1, 1, At, B1); PG8_BAR;
            }
        }
        if constexpr (ALIGN_EPI) { if (wr == 0) PG8_BAR; }
        if constexpr (!Epi::AFTER_DRAIN) { E(acc, cur, wr, wc, fr, fq); S.done(cur); }
        if (!has_next) break;
#pragma unroll
        for (int a = 0; a < 2; ++a)
#pragma unroll
            for (int b = 0; b < 2; ++b)
#pragma unroll
                for (int m = 0; m < 4; ++m)
#pragma unroll
                    for (int n = 0; n < 2; ++n) acc[a][b][m][n] = (f32x4){0.f, 0.f, 0.f, 0.f};
        cur = nxt; cA = nA; cB = nB; ++ui;
        if constexpr (ALIGN_EPI) { if (wr == 1) PG8_BAR; }
    }
    PG8_WAIT_V(0);
    if constexpr (!ALIGN_EPI) { if (wr == 0) PG8_BAR; }
    PG8_BAR;
    if constexpr (Epi::AFTER_DRAIN) { E.fused(acc, cur, wr, wc, fr, fq, lds, wid, lane); S.done(cur); }
#undef PG8_SA
#undef PG8_SB
#undef PG8_STAGE
#undef PG8_LDA
#undef PG8_LDB
#undef PG8_MMA
#undef PG8_WAIT_V
#undef PG8_WAIT_L
#undef PG8_BAR
#undef PG8_SCHED
}
}

#define LAS __attribute__((address_space(3)))
typedef unsigned short bf16;
typedef unsigned v4u __attribute__((ext_vector_type(4)));
typedef unsigned v2u __attribute__((ext_vector_type(2)));
typedef float f32x4 __attribute__((ext_vector_type(4)));
typedef float f32x16 __attribute__((ext_vector_type(16)));
typedef short bf16x8 __attribute__((ext_vector_type(8)));

constexpr int NTHREADS = 512, NWAVES = 8;
constexpr int MTOK = 65536, DM = 1024, SEQ = 8192, NBATCH = 8, DFF = 4096, NLAYER = 2;
constexpr int DIN = 7748, NINP = 4864;
constexpr float EPS = 1e-6f;

constexpr size_t MiB = 1u << 20;
constexpr size_t WS_CTL = 0, CTL_ZERO_BYTES = 1 * MiB;
constexpr size_t WS_LB = 1 * MiB;
constexpr size_t WS_SSQ = 1 * MiB + 65536;
constexpr size_t WS_W = 4 * MiB, W_LAYER = 37 * MiB;
constexpr size_t W_IN = 0, W_G = 9 * MiB + 512 * 1024, W_UA = W_G + 6 * MiB, W_UH = W_UA + MiB, W_UC = W_UH + MiB, W_O = W_UC + MiB, W_UP = W_O + 2 * MiB, W_DN = W_UP + 8 * MiB;
static_assert(W_DN + 8 * MiB <= W_LAYER, "weights map");
constexpr size_t WS_XB = 80 * MiB;
constexpr size_t ARENA = 208 * MiB;
constexpr size_t A_THQ = ARENA, A_THF = ARENA + 64 * MiB, A_THI = ARENA + 128 * MiB, A_TU = ARENA + 192 * MiB, A_TQ = ARENA + 256 * MiB,
                 A_TKV = ARENA + 320 * MiB, A_TIQ = ARENA + 352 * MiB, A_TIK = ARENA + 384 * MiB, A_TIW = ARENA + 392 * MiB, A_THG = ARENA + 393 * MiB,
                 A_TCB = ARENA + 457 * MiB, A_SEL = ARENA + 521 * MiB, A_HATTN = ARENA + 553 * MiB, A_HDEC = ARENA + 585 * MiB, A_HO = ARENA + 587 * MiB,
                 WS_END = ARENA + 651 * MiB;
constexpr size_t A_YB = ARENA, A_MIXED = ARENA + 128 * MiB, A_HIDDEN = ARENA;
constexpr int CW_TICKET = 16384;
constexpr int CW_BAR = 4096;

constexpr int LDS_MAIN = 131072, LDS_AUX = 131072, LDS_AUX_BYTES = 16384, MISC_OFF = LDS_AUX + LDS_AUX_BYTES, LDS_BYTES = MISC_OFF + 256;

__device__ __forceinline__ float bf2f(unsigned b) { return __uint_as_float(b << 16); }
__device__ __forceinline__ float bflo(unsigned u) { return __uint_as_float(u << 16); }
__device__ __forceinline__ float bfhi(unsigned u) { return __uint_as_float(u & 0xffff0000u); }
__device__ __forceinline__ unsigned f2bf(float f) { unsigned u = __float_as_uint(f); return (u + 0x7fffu + ((u >> 16) & 1u)) >> 16; }
typedef float f32x2c __attribute__((ext_vector_type(2)));
typedef __bf16 bf16x2c __attribute__((ext_vector_type(2)));
__device__ __forceinline__ unsigned pk2(float lo, float hi) { const f32x2c v = {lo, hi}; const bf16x2c r = __builtin_convertvector(v, bf16x2c); return __builtin_bit_cast(unsigned, r); }
__device__ __forceinline__ v4u pack8(const f32x4 a, const f32x4 b) { v4u w; w.x = pk2(a[0], a[1]); w.y = pk2(a[2], a[3]); w.z = pk2(b[0], b[1]); w.w = pk2(b[2], b[3]); return w; }
__device__ __forceinline__ void unpack8(const v4u w, float (&f)[8]) { f[0] = bflo(w.x); f[1] = bfhi(w.x); f[2] = bflo(w.y); f[3] = bfhi(w.y); f[4] = bflo(w.z); f[5] = bfhi(w.z); f[6] = bflo(w.w); f[7] = bfhi(w.w); }
#define LDS_WAIT() asm volatile("s_waitcnt lgkmcnt(0)" ::: "memory")
__device__ __forceinline__ float shx(float v, int m, int lane) { return __int_as_float(__builtin_amdgcn_ds_bpermute((lane ^ m) << 2, __float_as_int(v))); }
__device__ __forceinline__ float wave_sum(float v, int lane) {
#pragma unroll
    for (int o = 1; o < 64; o <<= 1) v += shx(v, o, lane);
    return v;
}
__device__ __forceinline__ float wave_max(float v, int lane) {
#pragma unroll
    for (int o = 1; o < 64; o <<= 1) v = fmaxf(v, shx(v, o, lane));
    return v;
}
__device__ __forceinline__ float sigmoidf_(float z) { return __builtin_amdgcn_rcpf(1.0f + __expf(-z)); }

struct Args { const float* in[16]; float* out; unsigned char* ws; int ph_lo, ph_hi; };
typedef const __attribute__((address_space(4))) Args* ArgsP;
typedef unsigned long long u64;
__device__ __forceinline__ unsigned ssq_fix(float s) { return (unsigned)(s * 65536.0f + 0.5f); }
__device__ __forceinline__ float ssq_val(u64 v) { return ((float)(unsigned)(v >> 32) * 4294967296.0f + (float)(unsigned)v) * (1.0f / 65536.0f); }
__device__ __forceinline__ ArgsP get_args() { const __attribute__((address_space(4))) void* p = (const __attribute__((address_space(4))) void*)__builtin_amdgcn_kernarg_segment_ptr(); asm volatile("" : "+s"(p)); return (ArgsP)p; }

namespace pg8 {

struct EpiInProj {
    static constexpr bool PERM = true, AFTER_DRAIN = false;
    const u64* ssq; bf16 *TQ, *TKV, *TIQ, *TIK; float* TIW; bf16 *THQ, *THF, *THI, *THG, *TCB, *TU;
    const float *qg, *kg, *lb;
    __device__ __forceinline__ void operator()(const f32x4 (&acc)[2][2][4][2], const Unit& u, int wr, int wc, int fr_in, int fq_in) const {
        int fr = fr_in, fq = fq_in; asm volatile("" : "+v"(fr), "+v"(fq)); const int lane_ = fq * 16 + fr; (void)lane_;
        const int t = u.pn;
        const int lc0 = 64 * wc + 8 * fq;
        u64 rs[2][4];
#pragma unroll
        for (int ai = 0; ai < 2; ++ai)
#pragma unroll
            for (int m = 0; m < 4; ++m) rs[ai][m] = ssq[(size_t)u.pm * 256 + ai * 128 + wr * 64 + m * 16 + fr];
        f32x4 cc[2][2];
        {   const float* cp = (t < 2) ? qg + 8 * fq : (t == 2) ? kg + 8 * fq : lb + 256 * ((t - 5) & 1) + lc0;
            const bool use = (t <= 2) || (t == 7) || (t == 8);
#pragma unroll
            for (int bj = 0; bj < 2; ++bj)
#pragma unroll
                for (int n = 0; n < 2; ++n) cc[bj][n] = use ? *(const f32x4*)(cp + 32 * bj + 4 * n) : (f32x4){0.f, 0.f, 0.f, 0.f}; }
#pragma unroll
        for (int ai = 0; ai < 2; ++ai)
#pragma unroll
            for (int m = 0; m < 4; ++m) {
                const size_t row = (size_t)u.pm * 256 + ai * 128 + wr * 64 + m * 16 + fr;
                const float rstd = rsqrtf(ssq_val(rs[ai][m]) * (1.0f / 1024.0f) + EPS);
                f32x4 v[2][2];
#pragma unroll
                for (int bj = 0; bj < 2; ++bj)
#pragma unroll
                    for (int n = 0; n < 2; ++n) v[bj][n] = acc[ai][bj][m][n] * rstd;
                if (t <= 2) {
                    const bool norm = (t < 2) || (wc < 2);
                    if (norm) {
                        float ss = 0.f;
#pragma unroll
                        for (int bj = 0; bj < 2; ++bj)
#pragma unroll
                            for (int n = 0; n < 2; ++n) ss += (v[bj][n][0] * v[bj][n][0] + v[bj][n][1] * v[bj][n][1]) + (v[bj][n][2] * v[bj][n][2] + v[bj][n][3] * v[bj][n][3]);
                        ss += shx(ss, 16, lane_); ss += shx(ss, 32, lane_);
                        const float r = rsqrtf(ss * (1.0f / 64.0f) + EPS);
#pragma unroll
                        for (int bj = 0; bj < 2; ++bj)
#pragma unroll
                            for (int n = 0; n < 2; ++n) v[bj][n] = v[bj][n] * r * cc[bj][n];
                    }
                    if (t < 2) { bf16* dst = TQ + row * 512 + 256 * t;
#pragma unroll
                        for (int bj = 0; bj < 2; ++bj) *(v4u*)(dst + lc0 + 32 * bj) = pack8(v[bj][0], v[bj][1]);
                    } else {
                        unsigned char* dst = (unsigned char*)TKV + row * 256;
#pragma unroll
                        for (int bj = 0; bj < 2; ++bj) { v2u w;
                            w.x = (unsigned)__builtin_amdgcn_cvt_pk_fp8_f32(v[bj][0][2], v[bj][0][3], __builtin_amdgcn_cvt_pk_fp8_f32(v[bj][0][0], v[bj][0][1], 0, false), true);
                            w.y = (unsigned)__builtin_amdgcn_cvt_pk_fp8_f32(v[bj][1][2], v[bj][1][3], __builtin_amdgcn_cvt_pk_fp8_f32(v[bj][1][0], v[bj][1][1], 0, false), true);
                            *(v2u*)(dst + lc0 + 32 * bj) = w; } }
                } else if (t == 3) {
#pragma unroll
                    for (int bj = 0; bj < 2; ++bj) *(v4u*)(TIQ + row * 256 + lc0 + 32 * bj) = pack8(v[bj][0], v[bj][1]);
                } else if (t == 4) {
                    if (wc == 0) {
#pragma unroll
                        for (int bj = 0; bj < 2; ++bj) *(v4u*)(TIK + row * 64 + lc0 + 32 * bj) = pack8(v[bj][0], v[bj][1]);
                    } else if (wc == 1 && fq == 0) {
                        *(f32x4*)(TIW + row * 4) = v[0][0];
                    }
                } else if (t <= 12) {
                    const int kind = (t - 5) >> 1, half = (t - 5) & 1;
                    bf16* base = kind == 0 ? THQ : kind == 1 ? THF : kind == 2 ? THI : THG;
                    if (kind == 1) {
#pragma unroll
                        for (int bj = 0; bj < 2; ++bj)
#pragma unroll
                            for (int n = 0; n < 2; ++n) { const f32x4 lbv = cc[bj][n];
#pragma unroll
                                for (int j = 0; j < 4; ++j) { const float z = fminf(fmaxf(v[bj][n][j], -60.f), 60.f); const float f = lbv[j] + (1.0f - lbv[j]) * sigmoidf_(z); v[bj][n][j] = __logf(f); } }
                    }
#pragma unroll
                    for (int bj = 0; bj < 2; ++bj) *(v4u*)(base + row * 512 + 256 * half + lc0 + 32 * bj) = pack8(v[bj][0], v[bj][1]);
                } else if (t <= 14) {
#pragma unroll
                    for (int bj = 0; bj < 2; ++bj) *(v4u*)(TCB + row * 512 + 256 * (t - 13) + lc0 + 32 * bj) = pack8(v[bj][0], v[bj][1]);
                } else {
                    *(v4u*)(TU + row * 512 + 128 * (t - 15) + 32 * wc + 8 * fq) = pack8(v[0][0] * v[1][0], v[0][1] * v[1][1]);
                }
            }
    }
};

struct EpiStoreBf16 {
    static constexpr bool PERM = true, AFTER_DRAIN = false;
    bf16* O; int ldc;
    __device__ __forceinline__ void operator()(const f32x4 (&acc)[2][2][4][2], const Unit& u, int wr, int wc, int fr_in, int fq_in) const {
        int fr = fr_in, fq = fq_in; asm volatile("" : "+v"(fr), "+v"(fq)); const int lane_ = fq * 16 + fr; (void)lane_;
#pragma unroll
        for (int ai = 0; ai < 2; ++ai)
#pragma unroll
            for (int m = 0; m < 4; ++m) { bf16* rowp = O + ((size_t)u.pm * 256 + ai * 128 + wr * 64 + m * 16 + fr) * ldc + u.pn * 256 + wc * 32 + 8 * fq;
#pragma unroll
                for (int bj = 0; bj < 2; ++bj) *(v4u*)(rowp + bj * 128) = pack8(acc[ai][bj][m][0], acc[ai][bj][m][1]); }
    }
};

template <bool FIRST> struct EpiGate {
    static constexpr bool PERM = true, AFTER_DRAIN = false;
    const u64* ssq; const bf16* Y; bf16* MX;
    __device__ __forceinline__ void operator()(const f32x4 (&acc)[2][2][4][2], const Unit& u, int wr, int wc, int fr_in, int fq_in) const {
        int fr = fr_in, fq = fq_in; asm volatile("" : "+v"(fr), "+v"(fq)); const int lane_ = fq * 16 + fr; (void)lane_;
        u64 rs[2][4];
#pragma unroll
        for (int ai = 0; ai < 2; ++ai)
#pragma unroll
            for (int m = 0; m < 4; ++m) rs[ai][m] = ssq[(size_t)u.pm * 256 + ai * 128 + wr * 64 + m * 16 + fr];
#pragma unroll
        for (int ai = 0; ai < 2; ++ai)
#pragma unroll
            for (int m = 0; m < 4; ++m) { const size_t row = (size_t)u.pm * 256 + ai * 128 + wr * 64 + m * 16 + fr;
                const float rstd = rsqrtf(ssq_val(rs[ai][m]) * (1.0f / 1024.0f) + EPS);
                const size_t off = row * 1024 + u.pn * 256 + wc * 32 + 8 * fq;
#pragma unroll
                for (int bj = 0; bj < 2; ++bj) { float y[8], o[8];
                    unpack8(*(const v4u*)(Y + off + bj * 128), y);
                    if (!FIRST) unpack8(*(const v4u*)(MX + off + bj * 128), o);
                    f32x4 r0, r1;
#pragma unroll
                    for (int j = 0; j < 4; ++j) { r0[j] = sigmoidf_(acc[ai][bj][m][0][j] * rstd) * y[j] + (FIRST ? 0.f : o[j]); r1[j] = sigmoidf_(acc[ai][bj][m][1][j] * rstd) * y[4 + j] + (FIRST ? 0.f : o[4 + j]); }
                    *(v4u*)(MX + off + bj * 128) = pack8(r0, r1); } }
    }
};

struct EpiResidual {
    static constexpr bool PERM = true, AFTER_DRAIN = false;
    bf16* XB; float* xout; u64* ssq_next; const u64* rs2;
    __device__ __forceinline__ void operator()(const f32x4 (&acc)[2][2][4][2], const Unit& u, int wr, int wc, int fr_in, int fq_in) const {
        int fr = fr_in, fq = fq_in; asm volatile("" : "+v"(fr), "+v"(fq)); const int lane_ = fq * 16 + fr; (void)lane_;
        u64 sc[2][4];
#pragma unroll
        for (int ai = 0; ai < 2; ++ai)
#pragma unroll
            for (int m = 0; m < 4; ++m) sc[ai][m] = rs2 ? rs2[(size_t)u.pm * 256 + ai * 128 + wr * 64 + m * 16 + fr] : 0ull;
        const size_t off0 = ((size_t)u.pm * 256 + wr * 64 + fr) * 1024 + u.pn * 256 + wc * 32 + 8 * fq;
        v4u xo[2][2][2];
#define ER_LOAD(buf_, bt_) do { _Pragma("unroll") for (int rr_ = 0; rr_ < 2; ++rr_) { const int q_ = 2 * (bt_) + rr_; const size_t o_ = off0 + (size_t)(128 * (q_ >> 2) + 16 * (q_ & 3)) * 1024; \
            _Pragma("unroll") for (int bj_ = 0; bj_ < 2; ++bj_) xo[buf_][rr_][bj_] = *(const v4u*)(XB + o_ + bj_ * 128); } } while (0)
        ER_LOAD(0, 0);
#pragma unroll
        for (int bt = 0; bt < 4; ++bt) {
            if (bt + 1 < 4) { if (bt & 1) ER_LOAD(0, bt + 1); else ER_LOAD(1, bt + 1); }
#pragma unroll
            for (int rr = 0; rr < 2; ++rr) { const int q = 2 * bt + rr, ai = q >> 2, m = q & 3;
                const size_t row = (size_t)u.pm * 256 + ai * 128 + wr * 64 + m * 16 + fr;
                const size_t off = off0 + (size_t)(128 * ai + 16 * m) * 1024;
                const float f = rs2 ? __builtin_amdgcn_rcpf(ssq_val(sc[ai][m]) * (1.0f / 1024.0f) + EPS) : 1.0f;
                float ss = 0.f;
#pragma unroll
                for (int bj = 0; bj < 2; ++bj) { float o[8]; unpack8(xo[bt & 1][rr][bj], o);
                    const f32x4 a = (f32x4){o[0], o[1], o[2], o[3]} + acc[ai][bj][m][0] * f;
                    const f32x4 b = (f32x4){o[4], o[5], o[6], o[7]} + acc[ai][bj][m][1] * f;
                    if (xout) { *(f32x4*)(xout + off + bj * 128) = a; *(f32x4*)(xout + off + bj * 128 + 4) = b; }
                    else *(v4u*)(XB + off + bj * 128) = pack8(a, b);
                    ss += (a[0] * a[0] + a[1] * a[1]) + (a[2] * a[2] + a[3] * a[3]) + (b[0] * b[0] + b[1] * b[1]) + (b[2] * b[2] + b[3] * b[3]); }
                if (ssq_next) { ss += shx(ss, 16, lane_); ss += shx(ss, 32, lane_); if (fq == 0) atomicAdd(ssq_next + row, (u64)ssq_fix(ss)); } }
        }
#undef ER_LOAD
    }
};

struct EpiMlpUp {
    static constexpr bool PERM = true, AFTER_DRAIN = false;
    bf16* H;
    __device__ __forceinline__ void operator()(const f32x4 (&acc)[2][2][4][2], const Unit& u, int wr, int wc, int fr_in, int fq_in) const {
        int fr = fr_in, fq = fq_in; asm volatile("" : "+v"(fr), "+v"(fq));
#pragma unroll
        for (int ai = 0; ai < 2; ++ai)
#pragma unroll
            for (int m = 0; m < 4; ++m) { const size_t row = (size_t)u.pm * 256 + ai * 128 + wr * 64 + m * 16 + fr;
                bf16* rowp = H + row * DFF + u.pn * 256 + wc * 32 + 8 * fq;
#pragma unroll
                for (int bj = 0; bj < 2; ++bj) { f32x4 a = acc[ai][bj][m][0], b = acc[ai][bj][m][1];
#pragma unroll
                    for (int j = 0; j < 4; ++j) { a[j] = fmaxf(a[j], 0.f); a[j] *= a[j]; b[j] = fmaxf(b[j], 0.f); b[j] *= b[j]; }
                    *(v4u*)(rowp + bj * 128) = pack8(a, b); } }
    }
};
}
#define XB_TMO      128
#define XB_XCNT(j)  (256  + 64 * (j))
#define XB_XSUB(j)  (1280 + 64 * (j))
#define XB_XGEN(j)  (2304 + 64 * (j))
#define XB_TOP      3328
#define XB_TOPGEN   3392
#define XCD_BAR_WORDS 3456
#define XB_SPIN_CAP (1u << 18)
#define LAS __attribute__((address_space(3)))

__device__ __forceinline__ unsigned xb_ld(unsigned* p)              { return __hip_atomic_load(p, __ATOMIC_RELAXED, __HIP_MEMORY_SCOPE_AGENT); }
__device__ __forceinline__ unsigned xb_add(unsigned* p, unsigned v) { return __hip_atomic_fetch_add(p, v, __ATOMIC_RELAXED, __HIP_MEMORY_SCOPE_AGENT); }
__device__ __forceinline__ unsigned xb_xcc_id() { return (unsigned)__builtin_amdgcn_s_getreg((3 << 11) | 20) & 0xFu; }
#define XB_SPIN(cond, bar) do { unsigned _sp = 0; while (cond) { __builtin_amdgcn_s_sleep(1); \
    if ((++_sp & 255u) == 0u) { if (xb_ld(&(bar)[XB_TMO])) break; if (_sp > XB_SPIN_CAP) { atomicAdd(&(bar)[XB_TMO], 1u); break; } } } } while (0)

struct XcdBarrier {
    unsigned* bar; unsigned x;
    volatile LAS unsigned* st;
};

__device__ __forceinline__ XcdBarrier xcd_barrier_post(unsigned* bar, volatile LAS unsigned* st) {
    XcdBarrier b; b.bar = bar; b.x = xb_xcc_id(); b.st = st;
    if (threadIdx.x == 0) (void)xb_add(&bar[XB_XCNT(b.x)], 1u);
    return b;
}
__device__ __forceinline__ void xcd_barrier_complete(unsigned* bar, unsigned x, unsigned& nloc, unsigned& nx) {
    const unsigned G = gridDim.x * gridDim.y * gridDim.z;
    unsigned sum, cnt, mine, sp = 0u;
    for (;;) {
        sum = 0u; cnt = 0u; mine = 0u;
#pragma unroll
        for (unsigned j = 0; j < 16; ++j) { const unsigned c = xb_ld(&bar[XB_XCNT(j)]); sum += c; cnt += (c > 0u) ? 1u : 0u; mine = (j == x) ? c : mine; }
        if (sum == G) break;
        __builtin_amdgcn_s_sleep(1);
        if ((++sp & 255u) == 0u) { if (xb_ld(&bar[XB_TMO])) break; if (sp > XB_SPIN_CAP) { atomicAdd(&bar[XB_TMO], 1u); break; } }
    }
    nloc = mine > 0u ? mine : 1u; nx = cnt > 0u ? cnt : 1u;
}

__device__ __forceinline__ void xcd_barrier(const XcdBarrier& b, const int tid_  ) {
    asm volatile("s_waitcnt vmcnt(0)" ::: "memory");
    __syncthreads();
    if (tid_ == 0) {
        unsigned* bar = b.bar;
        __builtin_amdgcn_s_waitcnt(0);
        unsigned nloc = b.st[0], nx = b.st[1];
        if (nloc == 0u) { xcd_barrier_complete(bar, b.x, nloc, nx); b.st[0] = nloc; b.st[1] = nx; }
        const unsigned old = xb_add(&bar[XB_XSUB(b.x)], 1u);
        const unsigned gen = old / nloc;
        if (old + 1u == (gen + 1u) * nloc) {
            __builtin_amdgcn_fence(__ATOMIC_RELEASE, "agent");
            asm volatile("s_waitcnt vmcnt(0)" ::: "memory");
            const unsigned og = xb_add(&bar[XB_TOP], 1u);
            const unsigned tg = og / nx;
            if (og + 1u == (tg + 1u) * nx) xb_add(&bar[XB_TOPGEN], 1u);
            else XB_SPIN(xb_ld(&bar[XB_TOPGEN]) == tg, bar);
            __builtin_amdgcn_fence(__ATOMIC_ACQUIRE, "agent");
            xb_add(&bar[XB_XGEN(b.x)], 1u);
            asm volatile("s_waitcnt vmcnt(0)" ::: "memory");
        } else {
            XB_SPIN(xb_ld(&bar[XB_XGEN(b.x)]) == gen, bar);
            __builtin_amdgcn_fence(__ATOMIC_ACQUIRE, "agent");
            asm volatile("s_waitcnt vmcnt(0)" ::: "memory");
        }
    }
    __syncthreads();
}


__device__ __forceinline__ int opaque_tid(int wv) { int t; asm volatile("v_mbcnt_lo_u32_b32 %0, -1, 0\n\tv_mbcnt_hi_u32_b32 %0, -1, %0\n\tv_lshl_add_u32 %0, %1, 6, %0" : "=&v"(t) : "s"(wv)); return t; }

__device__ __forceinline__ int inproj_src_col(int t, int p) {
    const int lc = 64 * ((p >> 5) & 3) + 32 * (p >> 7) + (p & 31);
    if (t <= 1) return 256 * t + lc;
    if (t == 2) return lc < 128 ? 512 + lc : 640 + (lc - 128);
    if (t == 3) return 768 + lc;
    if (t == 4) return lc < 64 ? 1024 + lc : (lc < 68 ? 1088 + (lc - 64) : -1);
    if (t <= 6) return 1092 + 256 * (t - 5) + lc;
    if (t <= 8) return 1604 + 256 * (t - 7) + lc;
    if (t <= 10) return 2116 + 256 * (t - 9) + lc;
    if (t <= 12) return 2628 + 256 * (t - 11) + lc;
    if (t <= 14) return 3140 + 256 * (t - 13) + lc;
    const int ct = t - 15, which = (lc >> 5) & 1, chn = 128 * ct + 32 * (lc >> 6) + (lc & 31);
    return (which ? 4164 : 3652) + chn;
}
__device__ __forceinline__ void cvt_item(const float* W, int ldw, int src, const float* gain, bf16* out, int K, int n0, int k0, LAS float* scr, int lane) {
    float v[32];
#pragma unroll
    for (int i = 0; i < 32; ++i) { const int kk = 2 * i + (lane >> 5); v[i] = (src >= 0) ? W[(size_t)(k0 + kk) * ldw + src] : 0.f; }
    if (gain) {
#pragma unroll
        for (int i = 0; i < 32; ++i) v[i] *= gain[k0 + 2 * i + (lane >> 5)];
    }
#pragma unroll
    for (int i = 0; i < 32; ++i) scr[(2 * i + (lane >> 5)) * 33 + (lane & 31)] = v[i];
    LDS_WAIT();
    const int c = lane & 7;
#pragma unroll
    for (int j = 0; j < 4; ++j) { const int n = (lane >> 3) + 8 * j; const LAS float* s = scr + (8 * c) * 33 + n;
        v4u o; o.x = pk2(s[0 * 33], s[1 * 33]); o.y = pk2(s[2 * 33], s[3 * 33]); o.z = pk2(s[4 * 33], s[5 * 33]); o.w = pk2(s[6 * 33], s[7 * 33]);
        *(v4u*)(out + (size_t)(n0 + n) * K + k0 + 8 * c) = o; }
    LDS_WAIT();
}
__device__ __forceinline__ void phase_prologue(ArgsP a, LAS unsigned char* lds, int G, int bid, int wv) {
    const int tid = opaque_tid(wv), lane = tid & 63, wave = tid >> 6;
    LAS float* scr = (LAS float*)(lds + wave * 16384);
    const int gw = bid * NWAVES + wave, NGW = G * NWAVES;
    unsigned char* ws = a->ws;
    constexpr int I0 = 16 * 152, I1 = 16 * 96, I2 = 8 * 32, I5 = 16 * 32, I6 = 16 * 128, I7 = 64 * 32;
    constexpr int ILAYER = I0 + I1 + 3 * I2 + I5 + I6 + I7;
    for (int it = gw; it < NLAYER * ILAYER; it += NGW) {
        const int l = it / ILAYER; int r = it % ILAYER;
        unsigned char* wl = ws + WS_W + (size_t)l * W_LAYER;
        const float* win = a->in[4] + (size_t)l * 1024 * DIN;
        if (r < I0) { const int kb = r / 152, nb = r % 152, n = nb * 32 + (lane & 31);
            cvt_item(win, DIN, inproj_src_col(n >> 8, n & 255), a->in[3] + l * 1024, (bf16*)(wl + W_IN), 1024, nb * 32, kb * 64, scr, lane); continue; } r -= I0;
        if (r < I1) { const int kb = r / 96, nb = r % 96;
            cvt_item(win, DIN, 4676 + nb * 32 + (lane & 31), a->in[3] + l * 1024, (bf16*)(wl + W_G), 1024, nb * 32, kb * 64, scr, lane); continue; } r -= I1;
        if (r < 3 * I2) { const int which = r / I2; r %= I2; const int kb = r / 32, nb = r % 32;
            cvt_item(a->in[9 + which] + (size_t)l * 512 * 1024, 1024, nb * 32 + (lane & 31), nullptr, (bf16*)(wl + W_UA + which * MiB), 512, nb * 32, kb * 64, scr, lane); continue; } r -= 3 * I2;
        if (r < I5) { const int kb = r / 32, nb = r % 32;
            cvt_item(a->in[12] + (size_t)l * 1024 * 1024, 1024, nb * 32 + (lane & 31), nullptr, (bf16*)(wl + W_O), 1024, nb * 32, kb * 64, scr, lane); continue; } r -= I5;
        if (r < I6) { const int kb = r / 128, nb = r % 128;
            cvt_item(a->in[14] + (size_t)l * 1024 * 4096, 4096, nb * 32 + (lane & 31), a->in[13] + l * 1024, (bf16*)(wl + W_UP), 1024, nb * 32, kb * 64, scr, lane); continue; } r -= I6;
        { const int kb = r / 32, nb = r % 32;
            cvt_item(a->in[15] + (size_t)l * 4096 * 1024, 1024, nb * 32 + (lane & 31), nullptr, (bf16*)(wl + W_DN), 4096, nb * 32, kb * 64, scr, lane); }
    }
    u64* ssq = (u64*)(ws + WS_SSQ);
    bf16* XB = (bf16*)(ws + WS_XB);
    for (int m0 = gw * 4; m0 < MTOK; m0 += NGW * 4) {
        f32x4 v[4][4];
#pragma unroll
        for (int rr = 0; rr < 4; ++rr) { const f32x4* xr = (const f32x4*)(a->in[0] + (size_t)(m0 + rr) * DM) + lane;
#pragma unroll
            for (int j = 0; j < 4; ++j) v[rr][j] = xr[64 * j]; }
#pragma unroll
        for (int rr = 0; rr < 4; ++rr) { const int m = m0 + rr; float s = 0.f;
#pragma unroll
            for (int j = 0; j < 4; ++j) s += (v[rr][j][0] * v[rr][j][0] + v[rr][j][1] * v[rr][j][1]) + (v[rr][j][2] * v[rr][j][2] + v[rr][j][3] * v[rr][j][3]);
            s = wave_sum(s, lane);
            v2u* o8 = (v2u*)(XB + (size_t)m * DM) + lane;
#pragma unroll
            for (int j = 0; j < 4; ++j) { v2u w; w.x = pk2(v[rr][j][0], v[rr][j][1]); w.y = pk2(v[rr][j][2], v[rr][j][3]); o8[64 * j] = w; }
            if (lane == 0) { ssq[m] = (u64)(s * 65536.0f + 0.5f); ssq[MTOK + m] = 0ull; ssq[2 * MTOK + m] = 0ull; ssq[3 * MTOK + m] = 0ull; } }
    }
    float* lb = (float*)(ws + WS_LB);
    for (int c = bid * NTHREADS + tid; c < 512; c += G * NTHREADS) { lb[c] = 0.f; lb[512 + c] = sigmoidf_(a->in[2][512 + c] - a->in[2][c]); }
}

__device__ __forceinline__ int wave_incl_scan(int x) {
    x += __builtin_amdgcn_update_dpp(0, x, 0x111, 0xf, 0xf, false);
    x += __builtin_amdgcn_update_dpp(0, x, 0x112, 0xf, 0xf, false);
    x += __builtin_amdgcn_update_dpp(0, x, 0x114, 0xf, 0xf, false);
    x += __builtin_amdgcn_update_dpp(0, x, 0x118, 0xf, 0xf, false);
    x += __builtin_amdgcn_update_dpp(0, x, 0x142, 0xa, 0xf, false);
    x += __builtin_amdgcn_update_dpp(0, x, 0x143, 0xc, 0xf, false);
    return x;
}
__device__ __forceinline__ int wave_suffix_sum(int s) { const int p = wave_incl_scan(s); return __builtin_amdgcn_readlane(p, 63) - p + s; }
constexpr int IDX_CAP = 1024;
__device__ __forceinline__ int select_top256(LAS int* buf, int n, LAS unsigned* hist, int lane) {
    int e[16];
#pragma unroll
    for (int i = 0; i < 16; ++i) e[i] = (lane + 64 * i < n) ? buf[lane + 64 * i] : (int)0x80000000;
    unsigned prefix = 0; int need = 256;
#pragma unroll 1
    for (int round = 0; round < 4; ++round) {
        const int shift = 24 - 8 * round;
        *(LAS v4u*)(hist + 4 * lane) = (v4u){0u, 0u, 0u, 0u};
        LDS_WAIT();
#pragma unroll
        for (int i = 0; i < 16; ++i) { const unsigned uu = (unsigned)e[i] ^ 0x80000000u;
            const bool match = (lane + 64 * i < n) && (round == 0 || (uu >> (shift + 8)) == prefix);
            if (match) __hip_atomic_fetch_add(hist + ((uu >> shift) & 255u), 1u, __ATOMIC_RELAXED, __HIP_MEMORY_SCOPE_WORKGROUP); }
        LDS_WAIT();
        const v4u h4 = *(LAS v4u*)(hist + 4 * lane);
        LDS_WAIT();
        const int s = (int)(h4.x + h4.y + h4.z + h4.w);
        const int S = wave_suffix_sum(s);
        const unsigned long long bal = __ballot(S >= need);
        const int L = __builtin_amdgcn_readfirstlane(63 - __builtin_clzll(bal | 1ull));
        const int SL = __builtin_amdgcn_readlane(S, L), hx = __builtin_amdgcn_readlane((int)h4.x, L), hy = __builtin_amdgcn_readlane((int)h4.y, L), hz = __builtin_amdgcn_readlane((int)h4.z, L), hw = __builtin_amdgcn_readlane((int)h4.w, L);
        const int above = SL - (hx + hy + hz + hw);
        int b;
        const int c3 = above + hw, c2 = c3 + hz, c1 = c2 + hy;
        if (c3 >= need) { b = 4 * L + 3; need -= above; }
        else if (c2 >= need) { b = 4 * L + 2; need -= c3; }
        else if (c1 >= need) { b = 4 * L + 1; need -= c2; }
        else { b = 4 * L; need -= c1; }
        prefix = (prefix << 8) | (unsigned)b;
    }
    int base = 0;
#pragma unroll
    for (int i = 0; i < 16; ++i) { const bool keep = (lane + 64 * i < n) && (((unsigned)e[i] ^ 0x80000000u) >= prefix);
        const unsigned long long bal = __ballot(keep);
        const int pos = base + __popcll(bal & ((1ull << lane) - 1ull));
        if (keep) buf[pos] = e[i];
        base += __popcll(bal); }
    LDS_WAIT();
    return (int)(prefix ^ 0x80000000u);
}

__device__ __forceinline__ void emit_selected(LAS int* kb, int n, LAS unsigned* bm, unsigned short* dst, int lane) {
    int pos[4];
#pragma unroll
    for (int i = 0; i < 4; ++i) { const int k = lane + 64 * i; pos[i] = (k < n) ? (int)(8191u - ((unsigned)kb[k] & 0x1fffu)) : -1; }
    *(LAS v4u*)(bm + 4 * lane) = (v4u){0u, 0u, 0u, 0u};
    LDS_WAIT();
#pragma unroll
    for (int i = 0; i < 4; ++i) if (pos[i] >= 0) __hip_atomic_fetch_or(bm + (pos[i] >> 5), 1u << (pos[i] & 31), __ATOMIC_RELAXED, __HIP_MEMORY_SCOPE_WORKGROUP);
    LDS_WAIT();
    const v4u w = *(const LAS v4u*)(bm + 4 * lane);
    const int c0 = __popc(w.x), c1 = __popc(w.y), c2 = __popc(w.z), c = c0 + c1 + c2 + __popc(w.w);
    const int incl = wave_incl_scan(c);
    const unsigned o = (unsigned)(incl - c);
    LAS unsigned* pre = (LAS unsigned*)kb;
    *(LAS v4u*)(pre + 4 * lane) = (v4u){o, o + (unsigned)c0, o + (unsigned)(c0 + c1), o + (unsigned)(c0 + c1 + c2)};
    LDS_WAIT();
#pragma unroll
    for (int i = 0; i < 4; ++i) { const int k = lane + 64 * i;
        if (pos[i] >= 0) { const int wd = pos[i] >> 5; const unsigned rank = pre[wd] + (unsigned)__popc(bm[wd] & ((1u << (pos[i] & 31)) - 1u)); dst[rank] = (unsigned short)pos[i]; }
        if (k >= n) dst[k] = (unsigned short)0; }
    LDS_WAIT();
}
__device__ __forceinline__ void indexer_group_slow(LAS unsigned char* lds, const bf16* TIQ, const bf16* TIK, const float* TIW, unsigned short* SEL, int b, int qg, int wv) {
    const int tid = opaque_tid(wv), lane = tid & 63, wave = __builtin_amdgcn_readfirstlane(tid >> 6);
    LAS int* buf = (LAS int*)lds;
    LAS int* cnt = (LAS int*)(lds + LDS_AUX);
    LAS int* thr = cnt + 32;
    LAS int* flg = cnt + 64;
    LAS unsigned* hist = (LAS unsigned*)(lds + LDS_AUX + 1024) + wave * 256;
    const int j = lane & 31, hh = lane >> 5;
    const int t0 = qg * 32, nt = qg + 1;
    const size_t rowbase = (size_t)b * SEQ;
    if (tid < 32) { cnt[tid] = 0; thr[tid] = (int)0x80000000; flg[tid & 1] = 0; }
    bf16x8 bq[4][4];
    {   const bf16* qp = TIQ + (rowbase + t0 + j) * 256 + hh * 8;
#pragma unroll
        for (int h = 0; h < 4; ++h)
#pragma unroll
            for (int ks = 0; ks < 4; ++ks) bq[h][ks] = *(const bf16x8*)(qp + h * 64 + ks * 16); }
    const f32x4 wgt = *(const f32x4*)(TIW + (rowbase + t0 + j) * 4);
    __syncthreads();
    LAS int* mybuf = buf + j * IDX_CAP;
    for (int it = 0; it * 8 < nt; ++it) {
        const int tile = it * 8 + wave;
        if (tile < nt) {
            const bf16* kp = TIK + (rowbase + tile * 32 + j) * 64 + hh * 8;
            bf16x8 ka[4];
#pragma unroll
            for (int ks = 0; ks < 4; ++ks) ka[ks] = *(const bf16x8*)(kp + ks * 16);
            f32x16 acc[4];
#pragma unroll
            for (int h = 0; h < 4; ++h) {
#pragma unroll
                for (int r = 0; r < 16; ++r) acc[h][r] = 0.f;
#pragma unroll
                for (int ks = 0; ks < 4; ++ks) acc[h] = __builtin_amdgcn_mfma_f32_32x32x16_bf16(ka[ks], bq[h][ks], acc[h], 0, 0, 0);
            }
            const int th = thr[j];
            const int tq = t0 + j;
            int keys[16]; unsigned mask = 0u;
#pragma unroll
            for (int r = 0; r < 16; ++r) {
                const int s = tile * 32 + 8 * (r >> 2) + 4 * hh + (r & 3);
                const float sc = __builtin_fmaf(wgt[3], __int_as_float(max(__float_as_int(acc[3][r]), 0)), __builtin_fmaf(wgt[2], __int_as_float(max(__float_as_int(acc[2][r]), 0)),
                                  __builtin_fmaf(wgt[1], __int_as_float(max(__float_as_int(acc[1][r]), 0)), wgt[0] * __int_as_float(max(__float_as_int(acc[0][r]), 0)))));
                const int si = __float_as_int(sc);
                const int o = si ^ ((si >> 31) & 0x7fffffff);
                const int key = (o & ~0x1fff) | (8191 - s);
                keys[r] = key;
                if (s <= tq && key > th) mask |= (1u << r);
            }
            if (mask) {
                int pos = __hip_atomic_fetch_add(cnt + j, __popc(mask), __ATOMIC_RELAXED, __HIP_MEMORY_SCOPE_WORKGROUP);
#pragma unroll
                for (int r = 0; r < 16; ++r) if (mask & (1u << r)) { mybuf[pos] = keys[r]; ++pos; }
            }
        }
        __syncthreads();
        if (tid < 32 && cnt[tid] > IDX_CAP - 256) flg[it & 1] = 1;
        if (tid == 0) flg[(it + 1) & 1] = 0;
        __syncthreads();
        if (flg[it & 1]) {
            for (int q = wave; q < 32; q += 8) { const int n = cnt[q];
                if (n > 512) { const int tnew = select_top256(buf + q * IDX_CAP, n, hist, lane); if (lane == 0) { cnt[q] = 256; thr[q] = tnew; } } }
            __syncthreads();
        }
    }
    for (int q = wave; q < 32; q += 8) {
        int n = cnt[q];
        if (n > 256) { (void)select_top256(buf + q * IDX_CAP, n, hist, lane); n = 256; }
        emit_selected(buf + q * IDX_CAP, n, hist, SEL + (rowbase + t0 + q) * 256, lane);
    }
    __syncthreads();
}
typedef float f32x2v __attribute__((ext_vector_type(2)));
template <int PASS>
__device__ __forceinline__ void idx_pass(const bf16* TIK, size_t rowbase, int t0, int nt, int wave, int j, int hh, const bf16x8 (&bq)[4][4], const f32x4 wgt,
                                         LAS unsigned* hist, LAS int* buf, LAS int* cnt, int thr) {
    bf16x8 ka[4];
    int tile = wave;
    if (tile < nt) { const bf16* kp = TIK + (rowbase + tile * 32 + j) * 64 + hh * 8;
#pragma unroll
        for (int ks = 0; ks < 4; ++ks) ka[ks] = *(const bf16x8*)(kp + ks * 16); }
    const int tq = t0 + j;
    const int hbase = j * 4096 + 2048;
    LAS int* mybuf = buf + j * IDX_CAP;
    const f32x2v w0 = (f32x2v){wgt[0], wgt[0]}, w1 = (f32x2v){wgt[1], wgt[1]}, w2 = (f32x2v){wgt[2], wgt[2]}, w3 = (f32x2v){wgt[3], wgt[3]};
#pragma unroll 1
    for (; tile < nt; tile += 8) {
        f32x16 acc[4];
#pragma unroll
        for (int h = 0; h < 4; ++h) {
#pragma unroll
            for (int r = 0; r < 16; ++r) acc[h][r] = 0.f;
#pragma unroll
            for (int ks = 0; ks < 4; ++ks) acc[h] = __builtin_amdgcn_mfma_f32_32x32x16_bf16(ka[ks], bq[h][ks], acc[h], 0, 0, 0);
        }
        if (tile + 8 < nt) { const bf16* kp = TIK + (rowbase + (tile + 8) * 32 + j) * 64 + hh * 8;
#pragma unroll
            for (int ks = 0; ks < 4; ++ks) ka[ks] = *(const bf16x8*)(kp + ks * 16); }
        const int lowb = 8191 - tile * 32 - 4 * hh;
        const int lim = tq - tile * 32 - 4 * hh;
        unsigned mask = 0u;
#pragma unroll
        for (int r2 = 0; r2 < 8; ++r2) {
            const int ra = 2 * r2, rb = 2 * r2 + 1;
#define IDX_RELU(x_) __int_as_float(max(__float_as_int(x_), 0))
            f32x2v sc;
            {   float r0 = IDX_RELU(acc[0][ra]), r1 = IDX_RELU(acc[1][ra]), r2 = IDX_RELU(acc[2][ra]), r3 = IDX_RELU(acc[3][ra]), t;
                asm("v_mul_f32 %0, %1, %2" : "=v"(t) : "v"(wgt[0]), "v"(r0)); asm("v_fmac_f32 %0, %1, %2" : "+v"(t) : "v"(wgt[1]), "v"(r1));
                asm("v_fmac_f32 %0, %1, %2" : "+v"(t) : "v"(wgt[2]), "v"(r2)); asm("v_fmac_f32 %0, %1, %2" : "+v"(t) : "v"(wgt[3]), "v"(r3)); sc.x = t; }
            {   float r0 = IDX_RELU(acc[0][rb]), r1 = IDX_RELU(acc[1][rb]), r2 = IDX_RELU(acc[2][rb]), r3 = IDX_RELU(acc[3][rb]), t;
                asm("v_mul_f32 %0, %1, %2" : "=v"(t) : "v"(wgt[0]), "v"(r0)); asm("v_fmac_f32 %0, %1, %2" : "+v"(t) : "v"(wgt[1]), "v"(r1));
                asm("v_fmac_f32 %0, %1, %2" : "+v"(t) : "v"(wgt[2]), "v"(r2)); asm("v_fmac_f32 %0, %1, %2" : "+v"(t) : "v"(wgt[3]), "v"(r3)); sc.y = t; }
#undef IDX_RELU
#pragma unroll
            for (int e = 0; e < 2; ++e) { const int r = 2 * r2 + e; const int ro = 8 * (r >> 2) + (r & 3);
                const int si = __float_as_int(e ? sc.y : sc.x);
                const int o = si ^ ((si >> 31) & 0x7fffffff);
                const int key = (o & ~0x1fff) | (lowb - ro);
                if (PASS == 1) { const unsigned val = (ro <= lim) ? (unsigned)__builtin_amdgcn_ubfe(o, 21, 1) * 0xffffu + 1u : 0u;
                    __hip_atomic_fetch_add((LAS unsigned*)((LAS unsigned char*)hist + hbase + (__builtin_amdgcn_sbfe(o, 22, 10) << 2)), val, __ATOMIC_RELAXED, __HIP_MEMORY_SCOPE_WORKGROUP); }
                else { acc[0][r] = __int_as_float(key); if (ro <= lim && key >= thr) mask |= (1u << r); } }
        }
        if (PASS == 2 && mask) {
            int pos = __hip_atomic_fetch_add(cnt + j, __popc(mask), __ATOMIC_RELAXED, __HIP_MEMORY_SCOPE_WORKGROUP);
#pragma unroll
            for (int r = 0; r < 16; ++r) if (mask & (1u << r)) { if (pos < IDX_CAP) mybuf[pos] = __float_as_int(acc[0][r]); ++pos; }
        }
    }
}
__device__ __forceinline__ int idx_find_bin(const LAS unsigned* hq, int lane, int& ncand) {
    v4u w[4];
#pragma unroll
    for (int i = 0; i < 4; ++i) w[i] = *(const LAS v4u*)(hq + 16 * lane + 4 * i);
    int s = 0;
#pragma unroll
    for (int i = 0; i < 4; ++i)
#pragma unroll
        for (int c = 0; c < 4; ++c) s += (int)(w[i][c] & 0xffffu) + (int)(w[i][c] >> 16);
    const int S = wave_suffix_sum(s);
    const int total = __builtin_amdgcn_readlane(S, 0);
    const unsigned long long bal = __ballot(S >= 256);
    const int L = __builtin_amdgcn_readfirstlane(63 - __builtin_clzll(bal | 1ull));
    int cum = S - s, rbin = 0, rcand = 0; bool found = false;
#pragma unroll
    for (int bb = 31; bb >= 0; --bb) { const int c = (int)((w[bb >> 3][(bb >> 1) & 3] >> (16 * (bb & 1))) & 0xffffu);
        cum += c; if (!found && cum >= 256) { found = true; rbin = 32 * lane + bb; rcand = cum; } }
    rbin = __builtin_amdgcn_readlane(rbin, L); rcand = __builtin_amdgcn_readlane(rcand, L);
    if (total <= 256) { ncand = total; return 0; }
    ncand = rcand; return rbin;
}
__device__ __forceinline__ void select_in_bin(LAS int* buf, int n_in, int binkey, LAS unsigned* hist, int lane) {
    const int n = __builtin_amdgcn_readfirstlane(n_in);
    int e[16]; int cab = 0;
#pragma unroll
    for (int i = 0; i < 16; ++i) { e[i] = (int)0x80000000; if (64 * i < n) { e[i] = (lane + 64 * i < n) ? buf[lane + 64 * i] : (int)0x80000000; cab += __popcll(__ballot((lane + 64 * i < n) && (e[i] >> 21) > binkey)); } }
    int need = 256 - cab; unsigned prefix = 0u;
#pragma unroll 1
    for (int round = 0; round < 3; ++round) {
        const int shift = 14 - 7 * round;
        if (lane < 32) *(LAS v4u*)(hist + 4 * lane) = (v4u){0u, 0u, 0u, 0u};
        LDS_WAIT();
#pragma unroll
        for (int i = 0; i < 16; ++i) if (64 * i < n) { const unsigned lowv = (unsigned)e[i] & 0x1fffffu;
            const bool match = ((e[i] >> 21) == binkey) && (lane + 64 * i < n) && (round == 0 || (lowv >> (shift + 7)) == prefix);
            if (match) __hip_atomic_fetch_add(hist + ((lowv >> shift) & 127u), 1u, __ATOMIC_RELAXED, __HIP_MEMORY_SCOPE_WORKGROUP); }
        LDS_WAIT();
        v4u h4 = (v4u){0u, 0u, 0u, 0u};
        if (lane < 32) h4 = *(LAS v4u*)(hist + 4 * lane);
        LDS_WAIT();
        const int s = (int)(h4.x + h4.y + h4.z + h4.w);
        const int S = wave_suffix_sum(s);
        const unsigned long long bal = __ballot(S >= need);
        const int L = __builtin_amdgcn_readfirstlane(63 - __builtin_clzll(bal | 1ull));
        const int SL = __builtin_amdgcn_readlane(S, L), hx = __builtin_amdgcn_readlane((int)h4.x, L), hy = __builtin_amdgcn_readlane((int)h4.y, L), hz = __builtin_amdgcn_readlane((int)h4.z, L), hw = __builtin_amdgcn_readlane((int)h4.w, L);
        const int above = SL - (hx + hy + hz + hw);
        int bsel; const int c3 = above + hw, c2 = c3 + hz, c1 = c2 + hy;
        if (c3 >= need) { bsel = 4 * L + 3; need -= above; }
        else if (c2 >= need) { bsel = 4 * L + 2; need -= c3; }
        else if (c1 >= need) { bsel = 4 * L + 1; need -= c2; }
        else { bsel = 4 * L; need -= c1; }
        prefix = (prefix << 7) | (unsigned)bsel;
    }
    int base = 0;
#pragma unroll
    for (int i = 0; i < 16; ++i) if (64 * i < n) { const int hb = e[i] >> 21; const bool keep = (lane + 64 * i < n) && (hb > binkey || (hb == binkey && ((unsigned)e[i] & 0x1fffffu) >= prefix));
        const unsigned long long bal = __ballot(keep);
        const int pos = base + __popcll(bal & ((1ull << lane) - 1ull));
        if (keep) buf[pos] = e[i];
        base += __popcll(bal); }
    LDS_WAIT();
}
__device__ __forceinline__ bool indexer_group(LAS unsigned char* lds, const bf16* TIQ, const bf16* TIK, const float* TIW, unsigned short* SEL, int b, int qg, int wv) {
    const int tid = opaque_tid(wv), lane = tid & 63, wave = __builtin_amdgcn_readfirstlane(tid >> 6);
    LAS unsigned* hist = (LAS unsigned*)lds;
    LAS int* buf = (LAS int*)lds;
    LAS int* cnt = (LAS int*)(lds + LDS_AUX);
    LAS int* thrq = cnt + 32;
    LAS int* fbk = cnt + 66;
    LAS unsigned* shist = (LAS unsigned*)(lds + LDS_AUX + 1024) + wave * 256;
    const int j = lane & 31, hh = lane >> 5;
    const int t0 = qg * 32, nt = qg + 1;
    const size_t rowbase = (size_t)b * SEQ;
#pragma unroll
    for (int i = 0; i < 16; ++i) *(LAS v4u*)(lds + (size_t)(tid + NTHREADS * i) * 16) = (v4u){0u, 0u, 0u, 0u};
    if (tid < 32) cnt[tid] = 0;
    if (tid == 0) fbk[0] = 0;
    bf16x8 bq[4][4];
    {   const bf16* qp = TIQ + (rowbase + t0 + j) * 256 + hh * 8;
#pragma unroll
        for (int h = 0; h < 4; ++h)
#pragma unroll
            for (int ks = 0; ks < 4; ++ks) bq[h][ks] = *(const bf16x8*)(qp + h * 64 + ks * 16); }
    const f32x4 wgt = *(const f32x4*)(TIW + (rowbase + t0 + j) * 4);
    __syncthreads();
    idx_pass<1>(TIK, rowbase, t0, nt, wave, j, hh, bq, wgt, hist, buf, cnt, 0);
    __syncthreads();
    for (int q = wave; q < 32; q += 8) { int ncand; const int bin = idx_find_bin(hist + q * 1024, lane, ncand);
        if (lane == 0) { thrq[q] = (bin == 0) ? (int)0x80000000 : (int)((unsigned)(bin - 1024) << 21); if (ncand > IDX_CAP) fbk[0] = 1; } }
    __syncthreads();
    if (fbk[0]) { __syncthreads(); return true; }
    idx_pass<2>(TIK, rowbase, t0, nt, wave, j, hh, bq, wgt, hist, buf, cnt, thrq[j]);
    __syncthreads();
    for (int q = wave; q < 32; q += 8) {
        int n = cnt[q]; n = n < IDX_CAP ? n : IDX_CAP;
        if (n > 256) { select_in_bin(buf + q * IDX_CAP, n, thrq[q] >> 21, shist, lane); n = 256; }
        emit_selected(buf + q * IDX_CAP, n, shist, SEL + (rowbase + t0 + q) * 256, lane);
    }
    __syncthreads();
    return false;
}
__device__ __forceinline__ void phase_indexer(ArgsP a, LAS unsigned char* lds, int l, int G, int bid, int wv) {
    unsigned char* ws = a->ws;
    const bf16* TIQ = (const bf16*)(ws + A_TIQ); const bf16* TIK = (const bf16*)(ws + A_TIK); const float* TIW = (const float*)(ws + A_TIW); unsigned short* SEL = (unsigned short*)(ws + A_SEL);
    const int b = bid & 7;
    unsigned* ticket = (unsigned*)(ws + WS_CTL) + CW_TICKET + (32 + l * 8 + b) * 64;
    volatile LAS int* tks = (volatile LAS int*)(lds + MISC_OFF + 128);
    const int tid0 = opaque_tid(wv);
#pragma unroll 1
    for (;;) {
        if (tid0 == 0) tks[0] = (int)__hip_atomic_fetch_add(ticket, 1u, __ATOMIC_RELAXED, __HIP_MEMORY_SCOPE_AGENT);
        __syncthreads();
        const int tk = __builtin_amdgcn_readfirstlane(tks[0]);
        __syncthreads();
        if (tk >= SEQ / 32) break;
        const int qg = SEQ / 32 - 1 - tk;
        const bool slow = indexer_group(lds, TIQ, TIK, TIW, SEL, b, qg, wv);
        if (slow) indexer_group_slow(lds, TIQ, TIK, TIW, SEL, b, qg, wv);
    }
}

constexpr int HPRP = 272;
constexpr int HPO_LF = 0, HPO_Q = 17408, HPO_I = 34816, HPO_TOT = 52224, HPO_QD = 54272, HPO_QX = HPO_QD + 64 * HPRP, HPO_KB = HPO_QX + 48 * HPRP, HPO_KD = HPO_KB + 48 * HPRP;
__device__ __forceinline__ void phase_hgrn_pre(ArgsP a, LAS unsigned char* lds, int G, int bid, int wv) {
    unsigned char* ws = a->ws;
    bf16* THQ = (bf16*)(ws + A_THQ); bf16* THF = (bf16*)(ws + A_THF); bf16* THI = (bf16*)(ws + A_THI); bf16* HATTN = (bf16*)(ws + A_HATTN); float* HDEC = (float*)(ws + A_HDEC);
    const int tid = opaque_tid(wv), lane = tid & 63, wave = tid >> 6, fr = lane & 15, fq = lane >> 4;
    const int sa = tid >> 7, d = tid & 127;
    LAS float* sTot = (LAS float*)(lds + HPO_TOT);
    constexpr int NU = (MTOK / 64) * 4;
    v4u ld[6];
#define HP_LOAD(u_) do { const int h_ = (u_) & 3; const size_t r0_ = (size_t)((u_) >> 2) * 64; _Pragma("unroll") for (int i_ = 0; i_ < 2; ++i_) { const int p_ = tid + NTHREADS * i_; \
        const size_t o_ = (r0_ + (p_ >> 4)) * 512 + h_ * 128 + (p_ & 15) * 8; ld[i_] = *(const v4u*)(THF + o_); ld[2 + i_] = *(const v4u*)(THQ + o_); ld[4 + i_] = *(const v4u*)(THI + o_); } } while (0)
    if (bid < NU) HP_LOAD(bid);
#pragma unroll 1
    for (int u = bid; u < NU; u += G) {
        const int h = u & 3; const size_t row0 = (size_t)(u >> 2) * 64;
#pragma unroll
        for (int i = 0; i < 2; ++i) { const int p = tid + NTHREADS * i, o = (p >> 4) * HPRP + (p & 15) * 16;
            *(LAS v4u*)(lds + HPO_LF + o) = ld[i]; *(LAS v4u*)(lds + HPO_Q + o) = ld[2 + i]; *(LAS v4u*)(lds + HPO_I + o) = ld[4 + i]; }
        __syncthreads();
        if (u + G < NU) HP_LOAD(u + G);
        float lf[16], qv[16], iv[16], gl[16];
#pragma unroll
        for (int i = 0; i < 16; ++i) { const int o = (sa * 16 + i) * HPRP + d * 2;
            lf[i] = bf2f(*(const LAS unsigned short*)(lds + HPO_LF + o)); qv[i] = bf2f(*(const LAS unsigned short*)(lds + HPO_Q + o)); iv[i] = bf2f(*(const LAS unsigned short*)(lds + HPO_I + o)); }
        { float g = 0.f;
#pragma unroll
          for (int i = 0; i < 16; ++i) { g += lf[i]; gl[i] = g; } }
        sTot[sa * 128 + d] = gl[15];
        __syncthreads();
        const float t0 = sTot[d], t1 = sTot[128 + d], t2 = sTot[256 + d], t3 = sTot[384 + d];
        const float pre = (sa > 0 ? t0 : 0.f) + (sa > 1 ? t1 : 0.f) + (sa > 2 ? t2 : 0.f);
        const float tsa = sa == 0 ? t0 : sa == 1 ? t1 : sa == 2 ? t2 : t3;
        const float glast = (t0 + t1) + (t2 + t3);
        const float cpre = __expf(pre);
        const float cr1 = __expf(sa == 2 ? t1 : t1 + t2);
        const float cr2 = __expf(t2);
        const float ctail = __expf(glast - (pre + tsa));
        float kt[16];
#pragma unroll
        for (int i = 0; i < 16; ++i) { const int t = sa * 16 + i, o = t * HPRP + d * 2; const float gi = gl[i];
            const float E = __expf(gi), Dc = __expf(fminf(-gi, 80.f)), Kb = __expf(tsa - gi), kk = 1.0f - __expf(lf[i]);
            const float qd = qv[i] * E;
            *(LAS unsigned short*)(lds + HPO_QD + o) = (unsigned short)f2bf(qd);
            if (sa == 2) *(LAS unsigned short*)(lds + HPO_QX + i * HPRP + d * 2) = (unsigned short)f2bf(qd * cr1);
            if (sa == 3) { *(LAS unsigned short*)(lds + HPO_QX + (16 + i) * HPRP + d * 2) = (unsigned short)f2bf(qd * cr1); *(LAS unsigned short*)(lds + HPO_QX + (32 + i) * HPRP + d * 2) = (unsigned short)f2bf(qd * cr2); }
            *(LAS unsigned short*)(lds + HPO_Q + o) = (unsigned short)f2bf(qd * cpre);
            *(LAS unsigned short*)(lds + HPO_KD + o) = (unsigned short)f2bf(kk * Dc);
            const float kb = kk * Kb;
            if (sa < 3) *(LAS unsigned short*)(lds + HPO_KB + o) = (unsigned short)f2bf(kb);
            kt[i] = kb * ctail; }
        {
            const size_t toff = (row0 + (d >> 1)) * 512 + h * 128 + (d & 1) * 64 + sa * 16;
            *(v4u*)(THF + toff) = pack8((f32x4){kt[0], kt[1], kt[2], kt[3]}, (f32x4){kt[4], kt[5], kt[6], kt[7]});
            *(v4u*)(THF + toff + 8) = pack8((f32x4){kt[8], kt[9], kt[10], kt[11]}, (f32x4){kt[12], kt[13], kt[14], kt[15]});
            *(v4u*)(THI + toff) = pack8((f32x4){iv[0], iv[1], iv[2], iv[3]}, (f32x4){iv[4], iv[5], iv[6], iv[7]});
            *(v4u*)(THI + toff + 8) = pack8((f32x4){iv[8], iv[9], iv[10], iv[11]}, (f32x4){iv[12], iv[13], iv[14], iv[15]}); }
        if (sa == 3) HDEC[(size_t)u * 128 + d] = __expf(glast);
        __syncthreads();
        bf16* at = HATTN + (size_t)u * 4096;
        for (int blk = wave; blk < 10; blk += 8) {
            const int ba = blk >= 6 ? 3 : blk >= 3 ? 2 : blk >= 1 ? 1 : 0, bb = blk - (ba * (ba + 1)) / 2;
            const int arow = (bb + 1 >= ba) ? HPO_QD + (16 * ba) * HPRP : HPO_QX + (ba == 2 ? 0 : 16 * (1 + bb)) * HPRP;
            const int brow = (bb == ba) ? HPO_KD + (16 * ba) * HPRP : HPO_KB + (16 * bb) * HPRP;
            f32x4 c = (f32x4){0.f, 0.f, 0.f, 0.f};
#pragma unroll
            for (int ks = 0; ks < 4; ++ks) { const bf16x8 A = *(const LAS bf16x8*)(lds + arow + fr * HPRP + (32 * ks + 8 * fq) * 2), B = *(const LAS bf16x8*)(lds + brow + fr * HPRP + (32 * ks + 8 * fq) * 2);
                c = __builtin_amdgcn_mfma_f32_16x16x32_bf16(A, B, c, 0, 0, 0); }
#pragma unroll
            for (int r = 0; r < 4; ++r) { const int tl = 4 * fq + r; const float v = (bb < ba || fr <= tl) ? c[r] : 0.f; at[(ba * 16 + tl) * 64 + bb * 16 + fr] = (bf16)f2bf(v); }
        }
        for (int e = tid; e < 6 * 256; e += NTHREADS) { const int z = e >> 8, za = z < 3 ? 0 : (z < 5 ? 1 : 2), zb = z < 3 ? z + 1 : (z < 5 ? z - 1 : 3);
            at[(za * 16 + ((e >> 4) & 15)) * 64 + zb * 16 + (e & 15)] = (bf16)0; }
#pragma unroll
        for (int i = 0; i < 2; ++i) { const int p = tid + NTHREADS * i; *(v4u*)(THQ + (row0 + (p >> 4)) * 512 + h * 128 + (p & 15) * 8) = *(const LAS v4u*)(lds + HPO_Q + (p >> 4) * HPRP + (p & 15) * 16); }
        __syncthreads();
    }
#undef HP_LOAD
}

__device__ __forceinline__ void phase_conv(ArgsP a, int l, int G, int bid, int wv) {
    unsigned char* ws = a->ws;
    bf16* TCB = (bf16*)(ws + A_TCB); const bf16* TU = (const bf16*)(ws + A_TU);
    const float* cw = a->in[8] + (size_t)l * 3 * 512;
    const int tid = opaque_tid(wv);
    const int c0 = (tid & 63) * 8;
    float w0[8], w1[8], w2[8];
#pragma unroll
    for (int j = 0; j < 8; ++j) { w0[j] = cw[c0 + j]; w1[j] = cw[512 + c0 + j]; w2[j] = cw[1024 + c0 + j]; }
    const int rstep = G * (NTHREADS / 64);
    v4u q2a[4], q1a[4], q0a[4], qba[4], q2b[4], q1b[4], q0b[4], qbb[4];
#define CONV_LOAD(q2_, q1_, q0_, qb_, r0_) do { _Pragma("unroll") for (int i = 0; i < 4; ++i) { const int row = (r0_) + i * rstep; const int t = row & (SEQ - 1); \
            if (row < MTOK) { const bf16* up = TU + (size_t)row * 512 + c0; \
                q2_[i] = *(const v4u*)up; qb_[i] = *(const v4u*)(TCB + (size_t)row * 512 + c0); \
                q1_[i] = (t >= 1) ? *(const v4u*)(up - 512) : (v4u){0u, 0u, 0u, 0u}; \
                q0_[i] = (t >= 2) ? *(const v4u*)(up - 1024) : (v4u){0u, 0u, 0u, 0u}; } } } while (0)
#define CONV_DO(q2_, q1_, q0_, qb_, r0_) do { _Pragma("unroll") for (int i = 0; i < 4; ++i) { const int row = (r0_) + i * rstep; \
            if (row < MTOK) { float u0[8], u1[8], u2[8], cb[8]; \
                unpack8(q2_[i], u2); unpack8(q1_[i], u1); unpack8(q0_[i], u0); unpack8(qb_[i], cb); \
                f32x4 ra, rb; \
                _Pragma("unroll") for (int j = 0; j < 8; ++j) { const float y = cb[j] * (w0[j] * u0[j] + w1[j] * u1[j] + w2[j] * u2[j]); if (j < 4) ra[j] = y; else rb[j - 4] = y; } \
                *(v4u*)(TCB + (size_t)row * 512 + c0) = pack8(ra, rb); } } } while (0)
    int r0 = bid * (NTHREADS / 64) + (tid >> 6);
    CONV_LOAD(q2a, q1a, q0a, qba, r0);
#pragma unroll 1
    for (; r0 < MTOK; r0 += 8 * rstep) {
        CONV_LOAD(q2b, q1b, q0b, qbb, r0 + 4 * rstep);
        CONV_DO(q2a, q1a, q0a, qba, r0);
        CONV_LOAD(q2a, q1a, q0a, qba, r0 + 8 * rstep);
        CONV_DO(q2b, q1b, q0b, qbb, r0 + 4 * rstep);
    }
#undef CONV_LOAD
#undef CONV_DO
}

__device__ __forceinline__ void hgrn_post_bh(const bf16* HO, bf16* THG, const float* gn, int b, int h, int tid) {
    const int lane = tid & 63, wave = tid >> 6, c8 = (lane & 15) * 8;
    float gv[8];
#pragma unroll
    for (int j = 0; j < 8; ++j) gv[j] = gn[c8 + j];
#pragma unroll 1
    for (int t0 = wave * 4 + (lane >> 4); t0 < SEQ; t0 += NWAVES * 4 * 8) {
        v4u ov[8], hv[8];
#pragma unroll
        for (int i = 0; i < 8; ++i) { const size_t off = ((size_t)b * SEQ + t0 + i * NWAVES * 4) * 512 + h * 128 + c8; ov[i] = *(const v4u*)(HO + off); hv[i] = *(const v4u*)(THG + off); }
#pragma unroll
        for (int i = 0; i < 8; ++i) { const size_t off = ((size_t)b * SEQ + t0 + i * NWAVES * 4) * 512 + h * 128 + c8;
            float o[8], hg[8];
            unpack8(ov[i], o); unpack8(hv[i], hg);
            float ss = 0.f;
#pragma unroll
            for (int j = 0; j < 8; ++j) ss += o[j] * o[j];
            ss += shx(ss, 1, lane); ss += shx(ss, 2, lane); ss += shx(ss, 4, lane); ss += shx(ss, 8, lane);
            const float r = rsqrtf(ss * (1.0f / 128.0f) + EPS);
            f32x4 r0, r1;
#pragma unroll
            for (int j = 0; j < 8; ++j) { const float y = o[j] * r * gv[j] * (hg[j] * sigmoidf_(hg[j])); if (j < 4) r0[j] = y; else r1[j - 4] = y; }
            *(v4u*)(THG + off) = pack8(r0, r1); }
    }
}
constexpr int HS_ATT = 0, HS_Q = 9216, HS_K = 26624, HS_DEC = 45056, HS_BUF = 45568;
__device__ __forceinline__ void phase_hgrn_seq(ArgsP a, LAS unsigned char* lds, int l, int G, int bid, int wv) {
    unsigned char* ws = a->ws;
    const bf16* THQ = (const bf16*)(ws + A_THQ); const bf16* THF = (const bf16*)(ws + A_THF); const bf16* THI = (const bf16*)(ws + A_THI);
    const bf16* HATTN = (const bf16*)(ws + A_HATTN); const float* HDEC = (const float*)(ws + A_HDEC); bf16* HO = (bf16*)(ws + A_HO);
    const int tid = opaque_tid(wv), lane = tid & 63, wave = __builtin_amdgcn_readfirstlane(tid >> 6), fr = lane & 15, fq = lane >> 4;
    constexpr int NCH = SEQ / 64;
    for (int u = bid; u < NBATCH * 4; u += G) {
        const int h = u & 3, b = u >> 2;
        const int vcol = 16 * wave + fr;
        f32x4 Sacc[8]; bf16x8 Sb[4];
#pragma unroll
        for (int i = 0; i < 8; ++i) Sacc[i] = (f32x4){0.f, 0.f, 0.f, 0.f};
#pragma unroll
        for (int i = 0; i < 4; ++i) Sb[i] = (bf16x8){0, 0, 0, 0, 0, 0, 0, 0};
        v4u st[5]; float stdec = 0.f; bf16x8 bi[2], bin[2];
#define HS_LOAD(c_) do { const size_t row0_ = (size_t)b * SEQ + (size_t)(c_) * 64; const size_t cu_ = ((size_t)b * NCH + (c_)) * 4 + h; \
            st[0] = *(const v4u*)(HATTN + cu_ * 4096 + (size_t)tid * 8); \
            _Pragma("unroll") for (int i_ = 0; i_ < 2; ++i_) { const int p_ = tid + 512 * i_; \
                st[1 + i_] = *(const v4u*)(THQ + (row0_ + (p_ >> 4)) * 512 + h * 128 + (p_ & 15) * 8); \
                const int d_ = p_ >> 3; st[3 + i_] = *(const v4u*)(THF + (row0_ + (d_ >> 1)) * 512 + h * 128 + (d_ & 1) * 64 + (p_ & 7) * 8); } \
            if (tid < 128) stdec = HDEC[cu_ * 128 + tid]; } while (0)
#define HS_WRITE(buf_) do { LAS unsigned char* q_ = lds + (buf_) * HS_BUF; \
            *(LAS v4u*)(q_ + HS_ATT + (tid >> 3) * 144 + (tid & 7) * 16) = st[0]; \
            _Pragma("unroll") for (int i_ = 0; i_ < 2; ++i_) { const int p_ = tid + 512 * i_; \
                *(LAS v4u*)(q_ + HS_Q + (p_ >> 4) * 272 + (p_ & 15) * 16) = st[1 + i_]; \
                *(LAS v4u*)(q_ + HS_K + (p_ >> 3) * 144 + (p_ & 7) * 16) = st[3 + i_]; } \
            if (tid < 128) *(LAS float*)(q_ + HS_DEC + tid * 4) = stdec; } while (0)
#define HS_LOADI(dst_, c_) do { const size_t row0_ = (size_t)b * SEQ + (size_t)(c_) * 64; \
            _Pragma("unroll") for (int ks_ = 0; ks_ < 2; ++ks_) dst_[ks_] = *(const bf16x8*)(THI + (row0_ + (vcol >> 1)) * 512 + h * 128 + (vcol & 1) * 64 + 32 * ks_ + 8 * fq); } while (0)
        __syncthreads();
        HS_LOAD(0); HS_LOADI(bin, 0);
        HS_WRITE(0);
        __syncthreads();
        HS_LOAD(1);
#pragma unroll 1
        for (int c = 0; c < NCH; ++c) {
            bi[0] = bin[0]; bi[1] = bin[1];
            if (c + 1 < NCH) HS_LOADI(bin, c + 1);
            const LAS unsigned char* buf = lds + (c & 1) * HS_BUF;
            const size_t row0 = (size_t)b * SEQ + (size_t)c * 64;
#pragma unroll
            for (int rt = 0; rt < 4; ++rt) {
                f32x4 acc = (f32x4){0.f, 0.f, 0.f, 0.f};
#pragma unroll
                for (int ks = 0; ks < 2; ++ks) { const bf16x8 A = *(const LAS bf16x8*)(buf + HS_ATT + (16 * rt + fr) * 144 + (32 * ks + 8 * fq) * 2);
                    acc = __builtin_amdgcn_mfma_f32_16x16x32_bf16(A, bi[ks], acc, 0, 0, 0); }
#pragma unroll
                for (int ks = 0; ks < 4; ++ks) { const v2u lo = *(const LAS v2u*)(buf + HS_Q + (16 * rt + fr) * 272 + (32 * ks + 4 * fq) * 2), hi = *(const LAS v2u*)(buf + HS_Q + (16 * rt + fr) * 272 + (32 * ks + 16 + 4 * fq) * 2);
                    const v4u t4 = (v4u){lo.x, lo.y, hi.x, hi.y};
                    acc = __builtin_amdgcn_mfma_f32_16x16x32_bf16(__builtin_bit_cast(bf16x8, t4), Sb[ks], acc, 0, 0, 0); }
#pragma unroll
                for (int r = 0; r < 4; ++r) HO[(row0 + 16 * rt + 4 * fq + r) * 512 + h * 128 + vcol] = (bf16)f2bf(acc[r]);
            }
#pragma unroll
            for (int dt = 0; dt < 8; ++dt) {
                const f32x4 dec4 = *(const LAS f32x4*)(buf + HS_DEC + (16 * dt + 4 * fq) * 4);
                Sacc[dt] = Sacc[dt] * dec4;
#pragma unroll
                for (int ks = 0; ks < 2; ++ks) { const bf16x8 A = *(const LAS bf16x8*)(buf + HS_K + (16 * dt + fr) * 144 + (32 * ks + 8 * fq) * 2);
                    Sacc[dt] = __builtin_amdgcn_mfma_f32_16x16x32_bf16(A, bi[ks], Sacc[dt], 0, 0, 0); }
            }
#pragma unroll
            for (int ks = 0; ks < 4; ++ks) { const v4u t4 = (v4u){pk2(Sacc[2 * ks][0], Sacc[2 * ks][1]), pk2(Sacc[2 * ks][2], Sacc[2 * ks][3]), pk2(Sacc[2 * ks + 1][0], Sacc[2 * ks + 1][1]), pk2(Sacc[2 * ks + 1][2], Sacc[2 * ks + 1][3])};
                Sb[ks] = __builtin_bit_cast(bf16x8, t4); }
            if (c + 1 < NCH) { HS_WRITE((c + 1) & 1); if (c + 2 < NCH) HS_LOAD(c + 2); }
            __syncthreads();
        }
#undef HS_LOAD
#undef HS_WRITE
#undef HS_LOADI
        asm volatile("s_waitcnt vmcnt(0)" ::: "memory");
        __syncthreads();
        hgrn_post_bh(HO, (bf16*)(ws + A_THG), a->in[7] + l * 128, b, h, tid);
    }
}

typedef float f32x2q __attribute__((ext_vector_type(2)));
typedef __bf16 bf16x2n __attribute__((ext_vector_type(2)));
__device__ __forceinline__ v4u fp8x8_to_bf16(unsigned u0, unsigned u1) {
    return (v4u){__builtin_bit_cast(unsigned, __builtin_amdgcn_cvt_scalef32_pk_bf16_fp8(u0, 1.0f, false)), __builtin_bit_cast(unsigned, __builtin_amdgcn_cvt_scalef32_pk_bf16_fp8(u0, 1.0f, true)),
                 __builtin_bit_cast(unsigned, __builtin_amdgcn_cvt_scalef32_pk_bf16_fp8(u1, 1.0f, false)), __builtin_bit_cast(unsigned, __builtin_amdgcn_cvt_scalef32_pk_bf16_fp8(u1, 1.0f, true))};
}
__device__ __forceinline__ v2u tr_read(unsigned addr) { v2u r; asm volatile("ds_read_b64_tr_b16 %0, %1" : "=&v"(r) : "v"(addr) : "memory"); return r; }
__device__ __forceinline__ int vimg_off(int row, int ch) { return 256 * row + 16 * (ch ^ (((row & 3) << 2) | ((row >> 2) & 3))); }
constexpr int AT_WAVE = 16896, AT_IDX = 16384;
__device__ __forceinline__ void phase_attention(ArgsP a, LAS unsigned char* lds, int l, int G, int bid, int wv) {
    unsigned char* ws = a->ws;
    bf16* TQ = (bf16*)(ws + A_TQ); bf16* TOUT = TQ; const unsigned char* TKV8 = (const unsigned char*)(ws + A_TKV);     const unsigned short* SEL = (const unsigned short*)(ws + A_SEL);
    const int tid = opaque_tid(wv), lane = tid & 63, wave = __builtin_amdgcn_readfirstlane(tid >> 6), fr = lane & 15, fq = lane >> 4;
    LAS unsigned char* vimg = lds + wave * AT_WAVE;
    LAS unsigned short* idxs = (LAS unsigned short*)(vimg + AT_IDX);
    const unsigned vimg_a = (unsigned)(unsigned long)vimg;
    bf16x8 bb;
    {   float f[8];
#pragma unroll
        for (int jj = 0; jj < 8; ++jj) f[jj] = (fr < 8) ? a->in[1][(8 * fq + jj) * 8 + fr] : 0.f;
        const v4u w = pack8((f32x4){f[0], f[1], f[2], f[3]}, (f32x4){f[4], f[5], f[6], f[7]}); bb = __builtin_bit_cast(bf16x8, w); }
    __syncthreads();
    const int b = bid & 7;
    unsigned* ticket = (unsigned*)(ws + WS_CTL) + CW_TICKET + (l * 8 + b) * 64;
    int tnext = 0;
    if (lane == 0) tnext = 4 * (int)__hip_atomic_fetch_add(ticket, 1u, __ATOMIC_RELAXED, __HIP_MEMORY_SCOPE_AGENT);
    const unsigned char* kvb = TKV8 + (size_t)b * SEQ * 256;
    const int tq = fr >> 2, tp = fr & 3;
    v2u idxnext = (v2u){0u, 0u};
    v4u pend = (v4u){0u, 0u, 0u, 0u}; int prow = -1;
    {   const int t0 = __builtin_amdgcn_readfirstlane(tnext);
        if (t0 < SEQ) idxnext = *(const v2u*)((const unsigned char*)(SEL + ((size_t)b * SEQ + t0) * 256) + (unsigned)lane * 8u); }
#pragma unroll 1
    for (;;) {
        const int t = __builtin_amdgcn_readfirstlane(tnext);
        if (t >= SEQ) break;
        if ((t & 3) == 3) { if (lane == 0) tnext = 4 * (int)__hip_atomic_fetch_add(ticket, 1u, __ATOMIC_RELAXED, __HIP_MEMORY_SCOPE_AGENT); } else tnext = t + 1;
        const size_t row = (size_t)b * SEQ + t;
        const int n = t + 1 < 256 ? t + 1 : 256;
        *(LAS v2u*)(idxs + lane * 4) = idxnext;
        bf16x8 bq[4];
        {   v4u w0 = (v4u){0u, 0u, 0u, 0u}, w1 = w0;
            if (fr < 8) { float f[8], g8[8]; const bf16* qp = TQ + row * 512 + fr * 64 + 16 * fq;
                unpack8(*(const v4u*)qp, f); unpack8(*(const v4u*)(qp + 8), g8);
                w0 = pack8((f32x4){f[0] * 0.125f, f[1] * 0.125f, f[2] * 0.125f, f[3] * 0.125f}, (f32x4){f[4] * 0.125f, f[5] * 0.125f, f[6] * 0.125f, f[7] * 0.125f});
                w1 = pack8((f32x4){g8[0] * 0.125f, g8[1] * 0.125f, g8[2] * 0.125f, g8[3] * 0.125f}, (f32x4){g8[4] * 0.125f, g8[5] * 0.125f, g8[6] * 0.125f, g8[7] * 0.125f}); }
            const v4u z = (v4u){0u, 0u, 0u, 0u}; const bool g1 = (fr >> 2) == 1;
            bq[0] = __builtin_bit_cast(bf16x8, g1 ? z : w0); bq[1] = __builtin_bit_cast(bf16x8, g1 ? z : w1);
            bq[2] = __builtin_bit_cast(bf16x8, g1 ? w0 : z); bq[3] = __builtin_bit_cast(bf16x8, g1 ? w1 : z); }
        LDS_WAIT();
        f32x4 acc[16]; v4u KA[16][2]; int kix[16];
#define AT_KLOAD(tile_) do { const int slot_ = (tile_) * 16 + fr; kix[tile_] = (int)idxs[slot_]; const unsigned char* kp_ = kvb + (size_t)kix[tile_] * 256 + 16 * fq; \
            KA[tile_][0] = *(const v4u*)kp_; KA[tile_][1] = *(const v4u*)(kp_ + 64); } while (0)
        AT_KLOAD(0); AT_KLOAD(1); AT_KLOAD(2);
        asm volatile("" ::: "memory");
#pragma unroll
        for (int tile = 0; tile < 16; ++tile) {
            if (tile + 3 < 16) { AT_KLOAD(tile + 3); asm volatile("" ::: "memory"); }
            const int dist = t - kix[tile];
            int bu = dist;
            if (dist >= 16) { bu = 16 + (int)((__log2f((float)dist) - 4.0f) * (16.0f / 3.0f)); bu = bu > 31 ? 31 : bu; }
            const unsigned mhot = ((bu >> 3) == fq) ? (0x3F80u << ((bu & 1) * 16)) : 0u; const int wsel = (bu >> 1) & 3;
            const v4u oh = (v4u){wsel == 0 ? mhot : 0u, wsel == 1 ? mhot : 0u, wsel == 2 ? mhot : 0u, wsel == 3 ? mhot : 0u};
            f32x4 c;
#pragma unroll
            for (int g = 0; g < 2; ++g) { const v4u kw = KA[tile][g];
                c = __builtin_amdgcn_mfma_f32_16x16x32_bf16(__builtin_bit_cast(bf16x8, fp8x8_to_bf16(kw.x, kw.y)), bq[2 * g], g == 0 ? (f32x4){0.f, 0.f, 0.f, 0.f} : c, 0, 0, 0);
                c = __builtin_amdgcn_mfma_f32_16x16x32_bf16(__builtin_bit_cast(bf16x8, fp8x8_to_bf16(kw.z, kw.w)), bq[2 * g + 1], c, 0, 0, 0); }
            acc[tile] = __builtin_amdgcn_mfma_f32_16x16x32_bf16(__builtin_bit_cast(bf16x8, oh), bb, c, 0, 0, 0);
        }
#undef AT_KLOAD
        if (prow >= 0) *(v4u*)(TOUT + (size_t)prow * 512 + lane * 8) = pend;
        v4u VS[8][4];
#define AT_VLOAD(hc_) do { _Pragma("unroll") for (int i_ = 0; i_ < 4; ++i_) { const int p_ = lane + 64 * i_; const int slot_ = 32 * (hc_) + (p_ >> 3); const int kidx_ = (int)idxs[slot_]; \
            VS[hc_][i_] = *(const v4u*)(kvb + (size_t)kidx_ * 256 + 128 + 16 * (p_ & 7)); } } while (0)
        AT_VLOAD(0);
        {   const int tn = __builtin_amdgcn_readfirstlane(tnext); unsigned lo8 = (unsigned)lane * 8u; asm volatile("" : "+v"(lo8));
            if (tn < SEQ) idxnext = *(const v2u*)((const unsigned char*)(SEL + ((size_t)b * SEQ + tn) * 256) + lo8); }
        asm volatile("" ::: "memory");
        if (n < 256) {
#pragma unroll
            for (int tile = 0; tile < 16; ++tile)
#pragma unroll
                for (int r = 0; r < 4; ++r) if (tile * 16 + 4 * fq + r >= n) acc[tile][r] = -INFINITY;
        }
        float mx = -INFINITY;
#pragma unroll
        for (int tile = 0; tile < 16; ++tile) mx = fmaxf(mx, fmaxf(fmaxf(acc[tile][0], acc[tile][1]), fmaxf(acc[tile][2], acc[tile][3])));
        mx = fmaxf(mx, shx(mx, 16, lane)); mx = fmaxf(mx, shx(mx, 32, lane));
        float sum = 0.f;
#pragma unroll
        for (int tile = 0; tile < 16; ++tile)
#pragma unroll
            for (int r = 0; r < 4; ++r) { const float e = __expf(acc[tile][r] - mx); acc[tile][r] = e; sum += e; }
        sum += shx(sum, 16, lane); sum += shx(sum, 32, lane);
        const float inv = __builtin_amdgcn_rcpf(sum);
        bf16x8 Pa[8];
#pragma unroll
        for (int k2 = 0; k2 < 8; ++k2) { const v4u w = pack8(acc[2 * k2] * inv, acc[2 * k2 + 1] * inv); Pa[k2] = __builtin_bit_cast(bf16x8, w); }
        f32x4 o[2][4];
#pragma unroll
        for (int hc = 0; hc < 8; ++hc) {
            if (hc + 1 < 8) { AT_VLOAD(hc + 1); asm volatile("" ::: "memory"); }
            const int rb = 32 * (hc & 1);
#pragma unroll
            for (int i = 0; i < 4; ++i) { const int p = lane + 64 * i, rowl = rb + (p >> 3), c16 = p & 7;
                *(LAS v4u*)(vimg + vimg_off(rowl, 2 * c16)) = fp8x8_to_bf16(VS[hc][i].x, VS[hc][i].y);
                *(LAS v4u*)(vimg + vimg_off(rowl, 2 * c16 + 1)) = fp8x8_to_bf16(VS[hc][i].z, VS[hc][i].w); }
            LDS_WAIT();
#pragma unroll
            for (int g = 0; g < 2; ++g) {
                v2u lo[4], hi[4];
#pragma unroll
                for (int dt = 0; dt < 4; ++dt) { const int ch = 8 * g + 2 * dt + (tp >> 1), r0 = rb + 4 * fq + tq;
                    lo[dt] = tr_read(vimg_a + vimg_off(r0, ch) + 8 * (tp & 1)); hi[dt] = tr_read(vimg_a + vimg_off(r0 + 16, ch) + 8 * (tp & 1)); }
                asm volatile("s_waitcnt lgkmcnt(0)" : "+v"(lo[0]), "+v"(lo[1]), "+v"(lo[2]), "+v"(lo[3]), "+v"(hi[0]), "+v"(hi[1]), "+v"(hi[2]), "+v"(hi[3]) :: "memory");
#pragma unroll
                for (int dt = 0; dt < 4; ++dt) { const v4u w = (v4u){lo[dt].x, lo[dt].y, hi[dt].x, hi[dt].y};
                    o[g][dt] = __builtin_amdgcn_mfma_f32_16x16x32_bf16(Pa[hc], __builtin_bit_cast(bf16x8, w), hc == 0 ? (f32x4){0.f, 0.f, 0.f, 0.f} : o[g][dt], 0, 0, 0); }
            }
        }
#undef AT_VLOAD
        if (fq < 2) {
#pragma unroll
            for (int g = 0; g < 2; ++g) if (g == fq) {
#pragma unroll
                for (int dt = 0; dt < 4; ++dt)
#pragma unroll
                    for (int r = 0; r < 4; ++r) *(LAS unsigned short*)(vimg + ((4 * g + r) * 64 + dt * 16 + fr) * 2) = (unsigned short)f2bf(o[g][dt][r]); }
        }
        LDS_WAIT();
        pend = *(const LAS v4u*)(vimg + lane * 16); prow = (int)row;
        LDS_WAIT();
    }
    if (prow >= 0) *(v4u*)(TOUT + (size_t)prow * 512 + lane * 8) = pend;
}
#ifndef ONE_LAUNCH
#define ONE_LAUNCH 1
#endif
constexpr int NPH_LAYER = 8, NPHASE = 1 + NLAYER * NPH_LAYER;

__global__ void __launch_bounds__(NTHREADS, 2) fwd_kernel(Args args_unused) {
    extern __shared__ __attribute__((aligned(16))) unsigned char lds_raw[];
    LAS unsigned char* lds = (LAS unsigned char*)lds_raw;
    volatile LAS unsigned* misc = (volatile LAS unsigned*)(lds + MISC_OFF);
    if (threadIdx.x < 64) misc[threadIdx.x] = 0u;
    const int wv = __builtin_amdgcn_readfirstlane((int)threadIdx.x >> 6);
    __syncthreads();
    if (get_args()->ph_hi - get_args()->ph_lo > 1) (void)xcd_barrier_post((unsigned*)(get_args()->ws + WS_CTL) + CW_BAR, misc + 8);
#define PH_LO (get_args()->ph_lo)
#define PH_HI (get_args()->ph_hi)
#define IN(k) (PH_LO <= (k) && (k) < PH_HI)
#define SEAM(k) do { if ((k) + 1 < PH_HI) { XcdBarrier b_; b_.bar = (unsigned*)(get_args()->ws + WS_CTL) + CW_BAR; b_.x = xb_xcc_id(); b_.st = misc + 8; xcd_barrier(b_, opaque_tid(wv)); } } while (0)
#define GRID ((int)gridDim.x)
#define BID ((int)blockIdx.x)

    if (IN(0)) { phase_prologue(get_args(), lds, GRID, BID, wv); SEAM(0); }

#pragma unroll 1
    for (int l = 0; l < NLAYER; ++l) {
        const int p0 = 1 + l * NPH_LAYER;
#define WSP (get_args()->ws)
        if (IN(p0 + 0)) {
            ArgsP a = get_args(); unsigned char* ws = a->ws;
            pg8::Gemm g{(const bf16*)(ws + WS_XB), (const bf16*)(ws + WS_W + (size_t)l * W_LAYER + W_IN), MTOK, NINP, 1024}; pg8::StaticOrder S; S.init(MTOK, NINP, GRID, BID);
            pg8::EpiInProj E{(const u64*)(ws + WS_SSQ) + (size_t)(2 * l) * MTOK, (bf16*)(ws + A_TQ), (bf16*)(ws + A_TKV), (bf16*)(ws + A_TIQ), (bf16*)(ws + A_TIK), (float*)(ws + A_TIW),
                             (bf16*)(ws + A_THQ), (bf16*)(ws + A_THF), (bf16*)(ws + A_THI), (bf16*)(ws + A_THG), (bf16*)(ws + A_TCB), (bf16*)(ws + A_TU),
                             a->in[5] + l * 64, a->in[6] + l * 64, (const float*)(ws + WS_LB) + l * 512};
            pg8::gemm_phase<pg8::EpiInProj, pg8::StaticOrder, true, true>(lds, g, S, E, opaque_tid(wv));
            SEAM(p0 + 0);
        }
        if (IN(p0 + 1)) {
            phase_indexer(get_args(), lds, l, GRID, BID, wv);
            phase_hgrn_pre(get_args(), lds, GRID, BID, wv);
            phase_conv(get_args(), l, GRID, BID, wv);
            SEAM(p0 + 1);
        }
        if (IN(p0 + 2)) {
            phase_hgrn_seq(get_args(), lds, l, GRID, BID, wv);
            __syncthreads();
            phase_attention(get_args(), lds, l, GRID, BID, wv);
            SEAM(p0 + 2);
        }
        if (IN(p0 + 4)) {
            {   unsigned char* ws = WSP; pg8::StaticOrder S; S.init(MTOK, 1024, GRID, BID); pg8::EpiStoreBf16 EY{(bf16*)(ws + A_YB), 1024};
                pg8::Gemm g{(const bf16*)(ws + A_TQ), (const bf16*)(ws + WS_W + (size_t)l * W_LAYER + W_UA), MTOK, 1024, 512}; pg8::gemm_phase<pg8::EpiStoreBf16, pg8::StaticOrder, true, true>(lds, g, S, EY, opaque_tid(wv)); }
            {   unsigned char* ws = WSP; pg8::StaticOrder S; S.init(MTOK, 1024, GRID, BID); pg8::EpiGate<true> E{(const u64*)(ws + WS_SSQ) + (size_t)(2 * l) * MTOK, (const bf16*)(ws + A_YB), (bf16*)(ws + A_MIXED)};
                pg8::Gemm g{(const bf16*)(ws + WS_XB), (const bf16*)(ws + WS_W + (size_t)l * W_LAYER + W_G), MTOK, 1024, 1024}; pg8::gemm_phase<pg8::EpiGate<true>, pg8::StaticOrder, true, true>(lds, g, S, E, opaque_tid(wv)); }
            {   unsigned char* ws = WSP; pg8::StaticOrder S; S.init(MTOK, 1024, GRID, BID); pg8::EpiStoreBf16 EY{(bf16*)(ws + A_YB), 1024};
                pg8::Gemm g{(const bf16*)(ws + A_THG), (const bf16*)(ws + WS_W + (size_t)l * W_LAYER + W_UH), MTOK, 1024, 512}; pg8::gemm_phase<pg8::EpiStoreBf16, pg8::StaticOrder, true, true>(lds, g, S, EY, opaque_tid(wv)); }
            {   unsigned char* ws = WSP; pg8::StaticOrder S; S.init(MTOK, 1024, GRID, BID); pg8::EpiGate<false> E{(const u64*)(ws + WS_SSQ) + (size_t)(2 * l) * MTOK, (const bf16*)(ws + A_YB), (bf16*)(ws + A_MIXED)};
                pg8::Gemm g{(const bf16*)(ws + WS_XB), (const bf16*)(ws + WS_W + (size_t)l * W_LAYER + W_G + 2 * MiB), MTOK, 1024, 1024}; pg8::gemm_phase<pg8::EpiGate<false>, pg8::StaticOrder, true, true>(lds, g, S, E, opaque_tid(wv)); }
            {   unsigned char* ws = WSP; pg8::StaticOrder S; S.init(MTOK, 1024, GRID, BID); pg8::EpiStoreBf16 EY{(bf16*)(ws + A_YB), 1024};
                pg8::Gemm g{(const bf16*)(ws + A_TCB), (const bf16*)(ws + WS_W + (size_t)l * W_LAYER + W_UC), MTOK, 1024, 512}; pg8::gemm_phase<pg8::EpiStoreBf16, pg8::StaticOrder, true, true>(lds, g, S, EY, opaque_tid(wv)); }
            {   unsigned char* ws = WSP; pg8::StaticOrder S; S.init(MTOK, 1024, GRID, BID); pg8::EpiGate<false> E{(const u64*)(ws + WS_SSQ) + (size_t)(2 * l) * MTOK, (const bf16*)(ws + A_YB), (bf16*)(ws + A_MIXED)};
                pg8::Gemm g{(const bf16*)(ws + WS_XB), (const bf16*)(ws + WS_W + (size_t)l * W_LAYER + W_G + 4 * MiB), MTOK, 1024, 1024}; pg8::gemm_phase<pg8::EpiGate<false>, pg8::StaticOrder, true, true>(lds, g, S, E, opaque_tid(wv)); }
            SEAM(p0 + 4);
        }
        if (IN(p0 + 5)) {
            ArgsP a = get_args(); unsigned char* ws = a->ws;
            pg8::Gemm g{(const bf16*)(ws + A_MIXED), (const bf16*)(ws + WS_W + (size_t)l * W_LAYER + W_O), MTOK, 1024, 1024}; pg8::StaticOrder S; S.init(MTOK, 1024, GRID, BID);
            pg8::EpiResidual E{(bf16*)(ws + WS_XB), (float*)nullptr, (u64*)(ws + WS_SSQ) + (size_t)(2 * l + 1) * MTOK, (const u64*)nullptr};
            pg8::gemm_phase<pg8::EpiResidual, pg8::StaticOrder, true, true>(lds, g, S, E, opaque_tid(wv));
            SEAM(p0 + 5);
        }
        if (IN(p0 + 6)) {
            unsigned char* ws = WSP;
            pg8::Gemm g{(const bf16*)(ws + WS_XB), (const bf16*)(ws + WS_W + (size_t)l * W_LAYER + W_UP), MTOK, DFF, 1024}; pg8::StaticOrder S; S.init(MTOK, DFF, GRID, BID);
            pg8::EpiMlpUp E{(bf16*)(ws + A_HIDDEN)};
            pg8::gemm_phase<pg8::EpiMlpUp, pg8::StaticOrder, true, true>(lds, g, S, E, opaque_tid(wv));
            SEAM(p0 + 6);
        }
        if (IN(p0 + 7)) {
            ArgsP a = get_args(); unsigned char* ws = a->ws;
            pg8::Gemm g{(const bf16*)(ws + A_HIDDEN), (const bf16*)(ws + WS_W + (size_t)l * W_LAYER + W_DN), MTOK, 1024, DFF}; pg8::StaticOrder S; S.init(MTOK, 1024, GRID, BID);
            pg8::EpiResidual E{(bf16*)(ws + WS_XB), (l + 1 < NLAYER) ? (float*)nullptr : a->out, (l + 1 < NLAYER) ? (u64*)(ws + WS_SSQ) + (size_t)(2 * l + 2) * MTOK : (u64*)nullptr, (const u64*)(ws + WS_SSQ) + (size_t)(2 * l + 1) * MTOK};
            pg8::gemm_phase<pg8::EpiResidual, pg8::StaticOrder, true, true>(lds, g, S, E, opaque_tid(wv));
            SEAM(p0 + 7);
        }
    }
#undef IN
#undef SEAM
}

extern "C" void kernel_launch(void* const* d_in, const int* in_sizes, int n_in, void* d_out, int out_size, void* d_ws, size_t ws_size, hipStream_t stream) {
    static int grid = 0;
    if (grid == 0) {
        if (n_in != 16 || in_sizes[0] != MTOK * DM || out_size != MTOK * DM || ws_size < WS_END) {
            fprintf(stderr, "kernel_launch: unexpected shapes / workspace (n_in %d, in0 %d, out %d, ws %zu, need %zu); nothing launched\n", n_in, n_in > 0 ? in_sizes[0] : -1, out_size, ws_size, (size_t)WS_END);
            grid = -1; return; }
        int dev = 0, cus = 0, per_cu = 0;
        if (hipGetDevice(&dev) != hipSuccess || hipDeviceGetAttribute(&cus, hipDeviceAttributeMultiprocessorCount, dev) != hipSuccess) { grid = -1; return; }
        if (hipFuncSetAttribute((const void*)fwd_kernel, hipFuncAttributeMaxDynamicSharedMemorySize, LDS_BYTES) != hipSuccess) { fprintf(stderr, "kernel_launch: hipFuncSetAttribute failed\n"); grid = -1; return; }
        if (hipOccupancyMaxActiveBlocksPerMultiprocessor(&per_cu, (const void*)fwd_kernel, NTHREADS, LDS_BYTES) != hipSuccess || per_cu < 1) fprintf(stderr, "kernel_launch: occupancy query reports %d\n", per_cu);
        (void)hipGetLastError();
        grid = cus;
    }
    if (grid < 0) return;
    if (hipMemsetAsync((char*)d_ws + WS_CTL, 0, CTL_ZERO_BYTES, stream) != hipSuccess) { fprintf(stderr, "kernel_launch: memset failed\n"); return; }
    Args a{};
    for (int i = 0; i < 16; ++i) a.in[i] = (const float*)d_in[i];
    a.out = (float*)d_out; a.ws = (unsigned char*)d_ws;
#if ONE_LAUNCH
    a.ph_lo = 0; a.ph_hi = NPHASE;
    hipLaunchKernelGGL(fwd_kernel, dim3(grid), dim3(NTHREADS), LDS_BYTES, stream, a);
#else
    for (int p = 0; p < NPHASE; ++p) { a.ph_lo = p; a.ph_hi = p + 1; hipLaunchKernelGGL(fwd_kernel, dim3(grid), dim3(NTHREADS), LDS_BYTES, stream, a); }
#endif
    const hipError_t le = hipPeekAtLastError();
    if (le != hipSuccess) fprintf(stderr, "kernel_launch: launch failed: %s\n", hipGetErrorName(le));
}
```

```cpp
#include <hip/hip_runtime.h>
#include <cstdio>
#include <cstdint>
#define ONE_LAUNCH 1
namespace pg8 {
#define PG8_LAS __attribute__((address_space(3)))
typedef unsigned short bf16_t;
typedef short bf16x8 __attribute__((ext_vector_type(8)));
typedef float f32x4 __attribute__((ext_vector_type(4)));
typedef unsigned u32x4 __attribute__((ext_vector_type(4)));
constexpr int BM = 256, BK = 64, HALF = 128, HTB = HALF * BK * 2  , STAGE_BYTES = 8 * HTB, NXCD = 8, WGM = 8;

__host__ __device__ __forceinline__ int lds_byte(int r, int c) { const int st = (r >> 4) * 2 + (c >> 5), rr = r & 15, cc = c & 31, ob = rr * 64 + cc * 2; return st * 1024 + (ob ^ (((ob >> 9) & 1) << 5)); }
__host__ __device__ __forceinline__ void stage_rc(int b, int& R, int& C) { const int st = b / 1024, sb = b % 1024, swz = sb ^ (((sb >> 9) & 1) << 5); R = (st >> 1) * 16 + swz / 64; C = (st & 1) * 32 + (swz % 64) / 2; }
__host__ __device__ __forceinline__ int perm32(int rho) { const int n = rho >> 4, i = rho & 15; return 8 * (i >> 2) + 4 * n + (i & 3); }

struct Unit { int pm, pn; };
struct Gemm { const bf16_t* A; const bf16_t* Bt; int M, N, K; };

struct StaticOrder {
    int nM, nN, nwg, G, c;
    __host__ __device__ void init(int M, int N, int G_, int c_) { nM = M / BM; nN = N / BM; nwg = nM * nN; G = G_; c = c_; }
    __host__ __device__ bool next(int i, Unit& u) const {
        const long L = (long)i * G + c; if (L >= nwg) return false;
        int wgid = (int)L; { const int q = nwg / NXCD, r = nwg % NXCD, xcd = wgid % NXCD, off = wgid / NXCD; wgid = (xcd < r ? xcd * (q + 1) : r * (q + 1) + (xcd - r) * q) + off; }
        const int nig = WGM * nN, gid = wgid / nig, fm = gid * WGM, gsz = (nM - fm) < WGM ? (nM - fm) : WGM;
        u.pm = fm + ((wgid % nig) % gsz); u.pn = (wgid % nig) / gsz; return true;
    }
    __device__ __forceinline__ void a_ready(const Unit&) const {}
    __device__ __forceinline__ void done(const Unit&) const {}
};
__device__ __forceinline__ unsigned cvt_pk_bf16(float lo, float hi) { unsigned r; asm volatile("v_cvt_pk_bf16_f32 %0, %1, %2" : "=v"(r) : "v"(lo), "v"(hi)); return r; }
typedef float f32x2 __attribute__((ext_vector_type(2)));
template <class Epi, class Sched, bool ALIGN_EPI = false, bool SP2 = false>
__device__ __forceinline__ void gemm_phase(PG8_LAS unsigned char* lds, const Gemm g, const Sched& S, const Epi& E, int tid_in) {
    int tid_l = tid_in; asm volatile("" : "+v"(tid_l));
    const int tid = tid_l, wid = __builtin_amdgcn_readfirstlane(tid >> 6), lane = tid & 63, wr = wid >> 2, wc = wid & 3, fr = lane & 15, fq = lane >> 4;
    const int K = g.K, nt = K / BK;
    unsigned voffA[2], voffB[2];
#pragma unroll
    for (int i = 0; i < 2; ++i) { int R, C; stage_rc(tid * 16 + i * 8192, R, C); const int Rb = Epi::PERM ? ((R & ~31) + perm32(R & 31)) : R;
        voffA[i] = (unsigned)(R * K + C) * 2u; voffB[i] = (unsigned)(Rb * K + C) * 2u; }
    const size_t kstep = (size_t)(BK * 2);
    const size_t hstep = (size_t)HALF * K * 2;
    const size_t tstep = 2 * hstep;
    const unsigned ldsw = (unsigned)wid * 1024u;
    const int aoff = lds_byte(wr * 64 + fr, fq * 8), boff = lds_byte(wc * 32 + fr, fq * 8);
#define PG8_SA(b, h) (((b) * 2 + (h)) * HTB)
#define PG8_SB(b, h) ((4 + (b) * 2 + (h)) * HTB)
#define PG8_STAGE(bufoff, gbase, voff) do { _Pragma("unroll") for (int _i = 0; _i < 2; ++_i) \
        __builtin_amdgcn_global_load_lds((const unsigned*)((const char*)(gbase) + (voff)[_i]), (PG8_LAS unsigned*)(lds + (bufoff) + ldsw + _i * 8192), 16, 0, 0); } while (0)
#define PG8_LDA(dst, b, h) do { _Pragma("unroll") for (int m = 0; m < 4; ++m) _Pragma("unroll") for (int k = 0; k < 2; ++k) dst[m][k] = *(const PG8_LAS bf16x8*)(lds + PG8_SA(b, h) + aoff + m * 2048 + k * 1024); } while (0)
#define PG8_LDB(dst, b, h) do { _Pragma("unroll") for (int n = 0; n < 2; ++n) _Pragma("unroll") for (int k = 0; k < 2; ++k) dst[n][k] = *(const PG8_LAS bf16x8*)(lds + PG8_SB(b, h) + boff + n * 2048 + k * 1024); } while (0)
#define PG8_MMA(ai, bj, At, Bt) do { __builtin_amdgcn_s_setprio(1); _Pragma("unroll") for (int m = 0; m < 4; ++m) _Pragma("unroll") for (int n = 0; n < 2; ++n) _Pragma("unroll") for (int k = 0; k < 2; ++k) \
        acc[ai][bj][m][n] = __builtin_amdgcn_mfma_f32_16x16x32_bf16(Bt[n][k], At[m][k], acc[ai][bj][m][n], 0, 0, 0); __builtin_amdgcn_s_setprio(0); } while (0)
#define PG8_WAIT_V(n) asm volatile("s_waitcnt vmcnt(" #n ")" ::: "memory")
#define PG8_WAIT_L(n) asm volatile("s_waitcnt lgkmcnt(" #n ")" ::: "memory")
#define PG8_BAR __builtin_amdgcn_s_barrier()
#define PG8_SCHED __builtin_amdgcn_sched_barrier(0)
    Unit cur, nxt; int ui = 0;
    if (!S.next(0, cur)) return;
    f32x4 acc[2][2][4][2];
#pragma unroll
    for (int a = 0; a < 2; ++a)
#pragma unroll
        for (int b = 0; b < 2; ++b)
#pragma unroll
            for (int m = 0; m < 4; ++m)
#pragma unroll
                for (int n = 0; n < 2; ++n) acc[a][b][m][n] = (f32x4){0.f, 0.f, 0.f, 0.f};
    bf16x8 At[4][2], B0[2][2], B1[2][2];
    const char* cA = (const char*)g.A + (size_t)cur.pm * tstep; const char* cB = (const char*)g.Bt + (size_t)cur.pn * tstep;
    S.a_ready(cur);
    if constexpr (SP2) {
        PG8_STAGE(PG8_SB(0, 0), cB, voffB); PG8_STAGE(PG8_SB(0, 1), cB + hstep, voffB); PG8_STAGE(PG8_SA(0, 0), cA, voffA); PG8_STAGE(PG8_SA(0, 1), cA + hstep, voffA);
        if (wr == 1) PG8_BAR;
        PG8_WAIT_V(2); PG8_BAR;
        PG8_STAGE(PG8_SB(1, 0), cB + kstep, voffB); PG8_STAGE(PG8_SA(1, 0), cA + kstep, voffA); PG8_STAGE(PG8_SB(1, 1), cB + hstep + kstep, voffB);
        PG8_WAIT_V(6); PG8_BAR;
    } else {
        PG8_STAGE(PG8_SB(0, 0), cB, voffB); PG8_STAGE(PG8_SA(0, 0), cA, voffA); PG8_STAGE(PG8_SB(0, 1), cB + hstep, voffB); PG8_STAGE(PG8_SA(0, 1), cA + hstep, voffA);
        if (wr == 1) PG8_BAR;
        PG8_WAIT_V(4); PG8_BAR;
        PG8_STAGE(PG8_SB(1, 0), cB + kstep, voffB); PG8_STAGE(PG8_SA(1, 0), cA + kstep, voffA); PG8_STAGE(PG8_SB(1, 1), cB + hstep + kstep, voffB);
        PG8_WAIT_V(6); PG8_BAR;
    }
    for (;;) {
        const bool has_next = S.next(ui + 1, nxt);
        const char* nA = has_next ? (const char*)g.A + (size_t)nxt.pm * tstep : cA; const char* nB = has_next ? (const char*)g.Bt + (size_t)nxt.pn * tstep : cB;
        for (int t = 0; t < nt; t += 2) {
            const bool last = (t == nt - 2);
            const char* a1 = cA + (size_t)(t + 1) * kstep;
            const char* a2 = last ? nA : cA + (size_t)(t + 2) * kstep; const char* b2 = last ? nB : cB + (size_t)(t + 2) * kstep;
            const char* a3 = a2 + kstep; const char* b3 = b2 + kstep;
            if (last && has_next) S.a_ready(nxt);
            if constexpr (SP2) {
            PG8_LDB(B0, 0, 0); PG8_LDB(B1, 0, 1); PG8_SCHED; PG8_LDA(At, 0, 0); PG8_STAGE(PG8_SA(1, 1), a1 + hstep, voffA);
            PG8_WAIT_V(8); PG8_WAIT_L(0); PG8_BAR; PG8_MMA(0, 0, At, B0); PG8_MMA(0, 1, At, B1); PG8_BAR; PG8_SCHED;
            PG8_LDA(At, 0, 1); PG8_STAGE(PG8_SB(0, 0), b2, voffB); PG8_STAGE(PG8_SB(0, 1), b2 + hstep, voffB); PG8_STAGE(PG8_SA(0, 0), a2, voffA);
            PG8_WAIT_V(8); PG8_WAIT_L(0); PG8_BAR; PG8_MMA(1, 0, At, B0); PG8_MMA(1, 1, At, B1); PG8_BAR; PG8_SCHED;
            PG8_LDB(B0, 1, 0); PG8_LDB(B1, 1, 1); PG8_SCHED; PG8_LDA(At, 1, 0); PG8_STAGE(PG8_SA(0, 1), a2 + hstep, voffA);
            PG8_WAIT_V(8); PG8_WAIT_L(0); PG8_BAR; PG8_MMA(0, 0, At, B0); PG8_MMA(0, 1, At, B1); PG8_BAR; PG8_SCHED;
            PG8_LDA(At, 1, 1); PG8_STAGE(PG8_SB(1, 0), b3, voffB); PG8_STAGE(PG8_SB(1, 1), b3 + hstep, voffB); PG8_STAGE(PG8_SA(1, 0), a3, voffA);
            PG8_WAIT_V(8); PG8_WAIT_L(0); PG8_BAR; PG8_MMA(1, 0, At, B0); PG8_MMA(1, 1, At, B1); PG8_BAR; PG8_SCHED;
            } else {
            PG8_LDB(B0, 0, 0); PG8_SCHED; PG8_LDA(At, 0, 0); PG8_STAGE(PG8_SA(1, 1), a1 + hstep, voffA);
            PG8_WAIT_L(8); PG8_BAR; PG8_WAIT_L(0); PG8_MMA(0, 0, At, B0); PG8_BAR; PG8_SCHED;
            PG8_LDB(B1, 0, 1); PG8_STAGE(PG8_SB(0, 0), b2, voffB);
            PG8_BAR; PG8_WAIT_L(0); PG8_MMA(0, 1, At, B1); PG8_BAR;
            PG8_LDA(At, 0, 1); PG8_STAGE(PG8_SA(0, 0), a2, voffA);
            PG8_BAR; PG8_WAIT_L(0); PG8_MMA(1, 0, At, B0); PG8_BAR; PG8_SCHED;
            PG8_STAGE(PG8_SB(0, 1), b2 + hstep, voffB);
            PG8_WAIT_V(6); PG8_BAR; PG8_MMA(1, 1, At, B1); PG8_BAR;
            PG8_LDB(B0, 1, 0); PG8_SCHED; PG8_LDA(At, 1, 0); PG8_STAGE(PG8_SA(0, 1), a2 + hstep, voffA);
            PG8_WAIT_L(8); PG8_BAR; PG8_WAIT_L(0); PG8_MMA(0, 0, At, B0); PG8_BAR; PG8_SCHED;
            PG8_LDB(B1, 1, 1); PG8_STAGE(PG8_SB(1, 0), b3, voffB);
            PG8_BAR; PG8_WAIT_L(0); PG8_MMA(0, 1, At, B1); PG8_BAR;
            PG8_LDA(At, 1, 1); PG8_STAGE(PG8_SA(1, 0), a3, voffA);
            PG8_BAR; PG8_WAIT_L(0); PG8_MMA(1, 0, At, B0); PG8_BAR; PG8_SCHED;
            PG8_STAGE(PG8_SB(1, 1), b3 + hstep, voffB);
            PG8_WAIT_V(6); PG8_BAR; PG8_MMA(1, 1, At, B1); PG8_BAR;
            }
        }
        if constexpr (ALIGN_EPI) { if (wr == 0) PG8_BAR; }
        if constexpr (!Epi::AFTER_DRAIN) { E(acc, cur, wr, wc, fr, fq); S.done(cur); }
        if (!has_next) break;
#pragma unroll
        for (int a = 0; a < 2; ++a)
#pragma unroll
            for (int b = 0; b < 2; ++b)
#pragma unroll
                for (int m = 0; m < 4; ++m)
#pragma unroll
                    for (int n = 0; n < 2; ++n) acc[a][b][m][n] = (f32x4){0.f, 0.f, 0.f, 0.f};
        cur = nxt; cA = nA; cB = nB; ++ui;
        if constexpr (ALIGN_EPI) { if (wr == 1) PG8_BAR; }
    }
    PG8_WAIT_V(0);
    if constexpr (!ALIGN_EPI) { if (wr == 0) PG8_BAR; }
    PG8_BAR;
    if constexpr (Epi::AFTER_DRAIN) { E.fused(acc, cur, wr, wc, fr, fq, lds, wid, lane); S.done(cur); }
#undef PG8_SA
#undef PG8_SB
#undef PG8_STAGE
#undef PG8_LDA
#undef PG8_LDB
#undef PG8_MMA
#undef PG8_WAIT_V
#undef PG8_WAIT_L
#undef PG8_BAR
#undef PG8_SCHED
}
}

#define LAS __attribute__((address_space(3)))
typedef unsigned short bf16;
typedef unsigned v4u __attribute__((ext_vector_type(4)));
typedef unsigned v2u __attribute__((ext_vector_type(2)));
typedef float f32x4 __attribute__((ext_vector_type(4)));
typedef float f32x16 __attribute__((ext_vector_type(16)));
typedef short bf16x8 __attribute__((ext_vector_type(8)));

constexpr int NTHREADS = 512, NWAVES = 8;
constexpr int MTOK = 65536, DM = 1024, SEQ = 8192, NBATCH = 8, DFF = 4096, NLAYER = 2;
constexpr int DIN = 7748, NINP = 4864;
constexpr float EPS = 1e-6f;

constexpr size_t MiB = 1u << 20;
constexpr size_t WS_CTL = 0, CTL_ZERO_BYTES = 1 * MiB;
constexpr size_t WS_LB = 1 * MiB;
constexpr size_t WS_SSQ = 1 * MiB + 65536;
constexpr size_t WS_W = 4 * MiB, W_LAYER = 37 * MiB;
constexpr size_t W_IN = 0, W_G = 9 * MiB + 512 * 1024, W_UA = W_G + 6 * MiB, W_UH = W_UA + MiB, W_UC = W_UH + MiB, W_O = W_UC + MiB, W_UP = W_O + 2 * MiB, W_DN = W_UP + 8 * MiB;
static_assert(W_DN + 8 * MiB <= W_LAYER, "weights map");
constexpr size_t WS_XB = 80 * MiB;
constexpr size_t ARENA = 208 * MiB;
constexpr size_t A_THQ = ARENA, A_THF = ARENA + 64 * MiB, A_THI = ARENA + 128 * MiB, A_TU = ARENA + 192 * MiB, A_TQ = ARENA + 256 * MiB,
                 A_TKV = ARENA + 320 * MiB, A_TIQ = ARENA + 352 * MiB, A_TIK = ARENA + 384 * MiB, A_TIW = ARENA + 392 * MiB, A_THG = ARENA + 393 * MiB,
                 A_TCB = ARENA + 457 * MiB, A_SEL = ARENA + 521 * MiB, A_HATTN = ARENA + 553 * MiB, A_HDEC = ARENA + 585 * MiB, A_HO = ARENA + 587 * MiB,
                 WS_END = ARENA + 651 * MiB;
constexpr size_t A_YB = ARENA, A_MIXED = ARENA + 128 * MiB, A_HIDDEN = ARENA;
constexpr int CW_TICKET = 16384;
constexpr int CW_BAR = 4096;

constexpr int LDS_MAIN = 131072, LDS_AUX = 131072, LDS_AUX_BYTES = 16384, MISC_OFF = LDS_AUX + LDS_AUX_BYTES, LDS_BYTES = MISC_OFF + 256;

__device__ __forceinline__ float bf2f(unsigned b) { return __uint_as_float(b << 16); }
__device__ __forceinline__ float bflo(unsigned u) { return __uint_as_float(u << 16); }
__device__ __forceinline__ float bfhi(unsigned u) { return __uint_as_float(u & 0xffff0000u); }
__device__ __forceinline__ unsigned f2bf(float f) { unsigned u = __float_as_uint(f); return (u + 0x7fffu + ((u >> 16) & 1u)) >> 16; }
typedef float f32x2c __attribute__((ext_vector_type(2)));
typedef __bf16 bf16x2c __attribute__((ext_vector_type(2)));
__device__ __forceinline__ unsigned pk2(float lo, float hi) { const f32x2c v = {lo, hi}; const bf16x2c r = __builtin_convertvector(v, bf16x2c); return __builtin_bit_cast(unsigned, r); }
__device__ __forceinline__ v4u pack8(const f32x4 a, const f32x4 b) { v4u w; w.x = pk2(a[0], a[1]); w.y = pk2(a[2], a[3]); w.z = pk2(b[0], b[1]); w.w = pk2(b[2], b[3]); return w; }
__device__ __forceinline__ void unpack8(const v4u w, float (&f)[8]) { f[0] = bflo(w.x); f[1] = bfhi(w.x); f[2] = bflo(w.y); f[3] = bfhi(w.y); f[4] = bflo(w.z); f[5] = bfhi(w.z); f[6] = bflo(w.w); f[7] = bfhi(w.w); }
#define LDS_WAIT() asm volatile("s_waitcnt lgkmcnt(0)" ::: "memory")
__device__ __forceinline__ float shx(float v, int m, int lane) { return __int_as_float(__builtin_amdgcn_ds_bpermute((lane ^ m) << 2, __float_as_int(v))); }
__device__ __forceinline__ float wave_sum(float v, int lane) {
#pragma unroll
    for (int o = 1; o < 64; o <<= 1) v += shx(v, o, lane);
    return v;
}
__device__ __forceinline__ float wave_max(float v, int lane) {
#pragma unroll
    for (int o = 1; o < 64; o <<= 1) v = fmaxf(v, shx(v, o, lane));
    return v;
}
__device__ __forceinline__ float sigmoidf_(float z) { return __builtin_amdgcn_rcpf(1.0f + __expf(-z)); }

struct Args { const float* in[16]; float* out; unsigned char* ws; int ph_lo, ph_hi; };
typedef const __attribute__((address_space(4))) Args* ArgsP;
typedef unsigned long long u64;
__device__ __forceinline__ unsigned ssq_fix(float s) { return (unsigned)(s * 65536.0f + 0.5f); }
__device__ __forceinline__ float ssq_val(u64 v) { return ((float)(unsigned)(v >> 32) * 4294967296.0f + (float)(unsigned)v) * (1.0f / 65536.0f); }
__device__ __forceinline__ ArgsP get_args() { const __attribute__((address_space(4))) void* p = (const __attribute__((address_space(4))) void*)__builtin_amdgcn_kernarg_segment_ptr(); asm volatile("" : "+s"(p)); return (ArgsP)p; }

namespace pg8 {

struct EpiInProj {
    static constexpr bool PERM = true, AFTER_DRAIN = false;
    const u64* ssq; bf16 *TQ, *TKV, *TIQ, *TIK; float* TIW; bf16 *THQ, *THF, *THI, *THG, *TCB, *TU;
    const float *qg, *kg, *lb;
    __device__ __forceinline__ void operator()(const f32x4 (&acc)[2][2][4][2], const Unit& u, int wr, int wc, int fr_in, int fq_in) const {
        int fr = fr_in, fq = fq_in; asm volatile("" : "+v"(fr), "+v"(fq)); const int lane_ = fq * 16 + fr; (void)lane_;
        const int t = u.pn;
        const int lc0 = 64 * wc + 8 * fq;
        u64 rs[2][4];
#pragma unroll
        for (int ai = 0; ai < 2; ++ai)
#pragma unroll
            for (int m = 0; m < 4; ++m) rs[ai][m] = ssq[(size_t)u.pm * 256 + ai * 128 + wr * 64 + m * 16 + fr];
        f32x4 cc[2][2];
        {   const float* cp = (t < 2) ? qg + 8 * fq : (t == 2) ? kg + 8 * fq : lb + 256 * ((t - 5) & 1) + lc0;
            const bool use = (t <= 2) || (t == 7) || (t == 8);
#pragma unroll
            for (int bj = 0; bj < 2; ++bj)
#pragma unroll
                for (int n = 0; n < 2; ++n) cc[bj][n] = use ? *(const f32x4*)(cp + 32 * bj + 4 * n) : (f32x4){0.f, 0.f, 0.f, 0.f}; }
#pragma unroll
        for (int ai = 0; ai < 2; ++ai)
#pragma unroll
            for (int m = 0; m < 4; ++m) {
                const size_t row = (size_t)u.pm * 256 + ai * 128 + wr * 64 + m * 16 + fr;
                const float rstd = rsqrtf(ssq_val(rs[ai][m]) * (1.0f / 1024.0f) + EPS);
                f32x4 v[2][2];
#pragma unroll
                for (int bj = 0; bj < 2; ++bj)
#pragma unroll
                    for (int n = 0; n < 2; ++n) v[bj][n] = acc[ai][bj][m][n] * rstd;
                if (t <= 2) {
                    const bool norm = (t < 2) || (wc < 2);
                    if (norm) {
                        float ss = 0.f;
#pragma unroll
                        for (int bj = 0; bj < 2; ++bj)
#pragma unroll
                            for (int n = 0; n < 2; ++n) ss += (v[bj][n][0] * v[bj][n][0] + v[bj][n][1] * v[bj][n][1]) + (v[bj][n][2] * v[bj][n][2] + v[bj][n][3] * v[bj][n][3]);
                        ss += shx(ss, 16, lane_); ss += shx(ss, 32, lane_);
                        const float r = rsqrtf(ss * (1.0f / 64.0f) + EPS);
#pragma unroll
                        for (int bj = 0; bj < 2; ++bj)
#pragma unroll
                            for (int n = 0; n < 2; ++n) v[bj][n] = v[bj][n] * r * cc[bj][n];
                    }
                    if (t < 2) { bf16* dst = TQ + row * 512 + 256 * t;
#pragma unroll
                        for (int bj = 0; bj < 2; ++bj) *(v4u*)(dst + lc0 + 32 * bj) = pack8(v[bj][0], v[bj][1]);
                    } else {
                        unsigned char* dst = (unsigned char*)TKV + row * 256;
#pragma unroll
                        for (int bj = 0; bj < 2; ++bj) { v2u w;
                            w.x = (unsigned)__builtin_amdgcn_cvt_pk_fp8_f32(v[bj][0][2], v[bj][0][3], __builtin_amdgcn_cvt_pk_fp8_f32(v[bj][0][0], v[bj][0][1], 0, false), true);
                            w.y = (unsigned)__builtin_amdgcn_cvt_pk_fp8_f32(v[bj][1][2], v[bj][1][3], __builtin_amdgcn_cvt_pk_fp8_f32(v[bj][1][0], v[bj][1][1], 0, false), true);
                            *(v2u*)(dst + lc0 + 32 * bj) = w; } }
                } else if (t == 3) {
#pragma unroll
                    for (int bj = 0; bj < 2; ++bj) *(v4u*)(TIQ + row * 256 + lc0 + 32 * bj) = pack8(v[bj][0], v[bj][1]);
                } else if (t == 4) {
                    if (wc == 0) {
#pragma unroll
                        for (int bj = 0; bj < 2; ++bj) *(v4u*)(TIK + row * 64 + lc0 + 32 * bj) = pack8(v[bj][0], v[bj][1]);
                    } else if (wc == 1 && fq == 0) {
                        *(f32x4*)(TIW + row * 4) = v[0][0];
                    }
                } else if (t <= 12) {
                    const int kind = (t - 5) >> 1, half = (t - 5) & 1;
                    bf16* base = kind == 0 ? THQ : kind == 1 ? THF : kind == 2 ? THI : THG;
                    if (kind == 1) {
#pragma unroll
                        for (int bj = 0; bj < 2; ++bj)
#pragma unroll
                            for (int n = 0; n < 2; ++n) { const f32x4 lbv = cc[bj][n];
#pragma unroll
                                for (int j = 0; j < 4; ++j) { const float z = fminf(fmaxf(v[bj][n][j], -60.f), 60.f); const float f = lbv[j] + (1.0f - lbv[j]) * sigmoidf_(z); v[bj][n][j] = __logf(f); } }
                    }
#pragma unroll
                    for (int bj = 0; bj < 2; ++bj) *(v4u*)(base + row * 512 + 256 * half + lc0 + 32 * bj) = pack8(v[bj][0], v[bj][1]);
                } else if (t <= 14) {
#pragma unroll
                    for (int bj = 0; bj < 2; ++bj) *(v4u*)(TCB + row * 512 + 256 * (t - 13) + lc0 + 32 * bj) = pack8(v[bj][0], v[bj][1]);
                } else {
                    *(v4u*)(TU + row * 512 + 128 * (t - 15) + 32 * wc + 8 * fq) = pack8(v[0][0] * v[1][0], v[0][1] * v[1][1]);
                }
            }
    }
};

struct EpiStoreBf16 {
    static constexpr bool PERM = true, AFTER_DRAIN = false;
    bf16* O; int ldc;
    __device__ __forceinline__ void operator()(const f32x4 (&acc)[2][2][4][2], const Unit& u, int wr, int wc, int fr_in, int fq_in) const {
        int fr = fr_in, fq = fq_in; asm volatile("" : "+v"(fr), "+v"(fq)); const int lane_ = fq * 16 + fr; (void)lane_;
#pragma unroll
        for (int ai = 0; ai < 2; ++ai)
#pragma unroll
            for (int m = 0; m < 4; ++m) { bf16* rowp = O + ((size_t)u.pm * 256 + ai * 128 + wr * 64 + m * 16 + fr) * ldc + u.pn * 256 + wc * 32 + 8 * fq;
#pragma unroll
                for (int bj = 0; bj < 2; ++bj) *(v4u*)(rowp + bj * 128) = pack8(acc[ai][bj][m][0], acc[ai][bj][m][1]); }
    }
};

template <bool FIRST> struct EpiGate {
    static constexpr bool PERM = true, AFTER_DRAIN = false;
    const u64* ssq; const bf16* Y; bf16* MX;
    __device__ __forceinline__ void operator()(const f32x4 (&acc)[2][2][4][2], const Unit& u, int wr, int wc, int fr_in, int fq_in) const {
        int fr = fr_in, fq = fq_in; asm volatile("" : "+v"(fr), "+v"(fq)); const int lane_ = fq * 16 + fr; (void)lane_;
        u64 rs[2][4];
#pragma unroll
        for (int ai = 0; ai < 2; ++ai)
#pragma unroll
            for (int m = 0; m < 4; ++m) rs[ai][m] = ssq[(size_t)u.pm * 256 + ai * 128 + wr * 64 + m * 16 + fr];
#pragma unroll
        for (int ai = 0; ai < 2; ++ai)
#pragma unroll
            for (int m = 0; m < 4; ++m) { const size_t row = (size_t)u.pm * 256 + ai * 128 + wr * 64 + m * 16 + fr;
                const float rstd = rsqrtf(ssq_val(rs[ai][m]) * (1.0f / 1024.0f) + EPS);
                const size_t off = row * 1024 + u.pn * 256 + wc * 32 + 8 * fq;
#pragma unroll
                for (int bj = 0; bj < 2; ++bj) { float y[8], o[8];
                    unpack8(*(const v4u*)(Y + off + bj * 128), y);
                    if (!FIRST) unpack8(*(const v4u*)(MX + off + bj * 128), o);
                    f32x4 r0, r1;
#pragma unroll
                    for (int j = 0; j < 4; ++j) { r0[j] = sigmoidf_(acc[ai][bj][m][0][j] * rstd) * y[j] + (FIRST ? 0.f : o[j]); r1[j] = sigmoidf_(acc[ai][bj][m][1][j] * rstd) * y[4 + j] + (FIRST ? 0.f : o[4 + j]); }
                    *(v4u*)(MX + off + bj * 128) = pack8(r0, r1); } }
    }
};

struct EpiResidual {
    static constexpr bool PERM = true, AFTER_DRAIN = false;
    bf16* XB; float* xout; u64* ssq_next; const u64* rs2;
    __device__ __forceinline__ void operator()(const f32x4 (&acc)[2][2][4][2], const Unit& u, int wr, int wc, int fr_in, int fq_in) const {
        int fr = fr_in, fq = fq_in; asm volatile("" : "+v"(fr), "+v"(fq)); const int lane_ = fq * 16 + fr; (void)lane_;
        u64 sc[2][4];
#pragma unroll
        for (int ai = 0; ai < 2; ++ai)
#pragma unroll
            for (int m = 0; m < 4; ++m) sc[ai][m] = rs2 ? rs2[(size_t)u.pm * 256 + ai * 128 + wr * 64 + m * 16 + fr] : 0ull;
        const size_t off0 = ((size_t)u.pm * 256 + wr * 64 + fr) * 1024 + u.pn * 256 + wc * 32 + 8 * fq;
        v4u xo[2][2][2];
#define ER_LOAD(buf_, bt_) do { _Pragma("unroll") for (int rr_ = 0; rr_ < 2; ++rr_) { const int q_ = 2 * (bt_) + rr_; const size_t o_ = off0 + (size_t)(128 * (q_ >> 2) + 16 * (q_ & 3)) * 1024; \
            _Pragma("unroll") for (int bj_ = 0; bj_ < 2; ++bj_) xo[buf_][rr_][bj_] = *(const v4u*)(XB + o_ + bj_ * 128); } } while (0)
        ER_LOAD(0, 0);
#pragma unroll
        for (int bt = 0; bt < 4; ++bt) {
            if (bt + 1 < 4) { if (bt & 1) ER_LOAD(0, bt + 1); else ER_LOAD(1, bt + 1); }
#pragma unroll
            for (int rr = 0; rr < 2; ++rr) { const int q = 2 * bt + rr, ai = q >> 2, m = q & 3;
                const size_t row = (size_t)u.pm * 256 + ai * 128 + wr * 64 + m * 16 + fr;
                const size_t off = off0 + (size_t)(128 * ai + 16 * m) * 1024;
                const float f = rs2 ? __builtin_amdgcn_rcpf(ssq_val(sc[ai][m]) * (1.0f / 1024.0f) + EPS) : 1.0f;
                float ss = 0.f;
#pragma unroll
                for (int bj = 0; bj < 2; ++bj) { float o[8]; unpack8(xo[bt & 1][rr][bj], o);
                    const f32x4 a = (f32x4){o[0], o[1], o[2], o[3]} + acc[ai][bj][m][0] * f;
                    const f32x4 b = (f32x4){o[4], o[5], o[6], o[7]} + acc[ai][bj][m][1] * f;
                    if (xout) { *(f32x4*)(xout + off + bj * 128) = a; *(f32x4*)(xout + off + bj * 128 + 4) = b; }
                    else *(v4u*)(XB + off + bj * 128) = pack8(a, b);
                    ss += (a[0] * a[0] + a[1] * a[1]) + (a[2] * a[2] + a[3] * a[3]) + (b[0] * b[0] + b[1] * b[1]) + (b[2] * b[2] + b[3] * b[3]); }
                if (ssq_next) { ss += shx(ss, 16, lane_); ss += shx(ss, 32, lane_); if (fq == 0) atomicAdd(ssq_next + row, (u64)ssq_fix(ss)); } }
        }
#undef ER_LOAD
    }
};

struct EpiMlpUp {
    static constexpr bool PERM = true, AFTER_DRAIN = false;
    bf16* H;
    __device__ __forceinline__ void operator()(const f32x4 (&acc)[2][2][4][2], const Unit& u, int wr, int wc, int fr_in, int fq_in) const {
        int fr = fr_in, fq = fq_in; asm volatile("" : "+v"(fr), "+v"(fq));
#pragma unroll
        for (int ai = 0; ai < 2; ++ai)
#pragma unroll
            for (int m = 0; m < 4; ++m) { const size_t row = (size_t)u.pm * 256 + ai * 128 + wr * 64 + m * 16 + fr;
                bf16* rowp = H + row * DFF + u.pn * 256 + wc * 32 + 8 * fq;
#pragma unroll
                for (int bj = 0; bj < 2; ++bj) { f32x4 a = acc[ai][bj][m][0], b = acc[ai][bj][m][1];
#pragma unroll
                    for (int j = 0; j < 4; ++j) { a[j] = fmaxf(a[j], 0.f); a[j] *= a[j]; b[j] = fmaxf(b[j], 0.f); b[j] *= b[j]; }
                    *(v4u*)(rowp + bj * 128) = pack8(a, b); } }
    }
};
}
#define XB_TMO      128
#define XB_XCNT(j)  (256  + 64 * (j))
#define XB_XSUB(j)  (1280 + 64 * (j))
#define XB_XGEN(j)  (2304 + 64 * (j))
#define XB_TOP      3328
#define XB_TOPGEN   3392
#define XCD_BAR_WORDS 3456
#define XB_SPIN_CAP (1u << 18)
#define LAS __attribute__((address_space(3)))

__device__ __forceinline__ unsigned xb_ld(unsigned* p)              { return __hip_atomic_load(p, __ATOMIC_RELAXED, __HIP_MEMORY_SCOPE_AGENT); }
__device__ __forceinline__ unsigned xb_add(unsigned* p, unsigned v) { return __hip_atomic_fetch_add(p, v, __ATOMIC_RELAXED, __HIP_MEMORY_SCOPE_AGENT); }
__device__ __forceinline__ unsigned xb_xcc_id() { return (unsigned)__builtin_amdgcn_s_getreg((3 << 11) | 20) & 0xFu; }
#define XB_SPIN(cond, bar) do { unsigned _sp = 0; while (cond) { __builtin_amdgcn_s_sleep(1); \
    if ((++_sp & 255u) == 0u) { if (xb_ld(&(bar)[XB_TMO])) break; if (_sp > XB_SPIN_CAP) { atomicAdd(&(bar)[XB_TMO], 1u); break; } } } } while (0)

struct XcdBarrier {
    unsigned* bar; unsigned x;
    volatile LAS unsigned* st;
};

__device__ __forceinline__ XcdBarrier xcd_barrier_post(unsigned* bar, volatile LAS unsigned* st) {
    XcdBarrier b; b.bar = bar; b.x = xb_xcc_id(); b.st = st;
    if (threadIdx.x == 0) (void)xb_add(&bar[XB_XCNT(b.x)], 1u);
    return b;
}
__device__ __forceinline__ void xcd_barrier_complete(unsigned* bar, unsigned x, unsigned& nloc, unsigned& nx) {
    const unsigned G = gridDim.x * gridDim.y * gridDim.z;
    unsigned sum, cnt, mine, sp = 0u;
    for (;;) {
        sum = 0u; cnt = 0u; mine = 0u;
#pragma unroll
        for (unsigned j = 0; j < 16; ++j) { const unsigned c = xb_ld(&bar[XB_XCNT(j)]); sum += c; cnt += (c > 0u) ? 1u : 0u; mine = (j == x) ? c : mine; }
        if (sum == G) break;
        __builtin_amdgcn_s_sleep(1);
        if ((++sp & 255u) == 0u) { if (xb_ld(&bar[XB_TMO])) break; if (sp > XB_SPIN_CAP) { atomicAdd(&bar[XB_TMO], 1u); break; } }
    }
    nloc = mine > 0u ? mine : 1u; nx = cnt > 0u ? cnt : 1u;
}

__device__ __forceinline__ void xcd_barrier(const XcdBarrier& b, const int tid_  ) {
    asm volatile("s_waitcnt vmcnt(0)" ::: "memory");
    __syncthreads();
    if (tid_ == 0) {
        unsigned* bar = b.bar;
        __builtin_amdgcn_s_waitcnt(0);
        unsigned nloc = b.st[0], nx = b.st[1];
        if (nloc == 0u) { xcd_barrier_complete(bar, b.x, nloc, nx); b.st[0] = nloc; b.st[1] = nx; }
        const unsigned old = xb_add(&bar[XB_XSUB(b.x)], 1u);
        const unsigned gen = old / nloc;
        if (old + 1u == (gen + 1u) * nloc) {
            __builtin_amdgcn_fence(__ATOMIC_RELEASE, "agent");
            asm volatile("s_waitcnt vmcnt(0)" ::: "memory");
            const unsigned og = xb_add(&bar[XB_TOP], 1u);
            const unsigned tg = og / nx;
            if (og + 1u == (tg + 1u) * nx) xb_add(&bar[XB_TOPGEN], 1u);
            else XB_SPIN(xb_ld(&bar[XB_TOPGEN]) == tg, bar);
            __builtin_amdgcn_fence(__ATOMIC_ACQUIRE, "agent");
            xb_add(&bar[XB_XGEN(b.x)], 1u);
            asm volatile("s_waitcnt vmcnt(0)" ::: "memory");
        } else {
            XB_SPIN(xb_ld(&bar[XB_XGEN(b.x)]) == gen, bar);
            __builtin_amdgcn_fence(__ATOMIC_ACQUIRE, "agent");
            asm volatile("s_waitcnt vmcnt(0)" ::: "memory");
        }
    }
    __syncthreads();
}


__device__ __forceinline__ int opaque_tid(int wv) { int t; asm volatile("v_mbcnt_lo_u32_b32 %0, -1, 0\n\tv_mbcnt_hi_u32_b32 %0, -1, %0\n\tv_lshl_add_u32 %0, %1, 6, %0" : "=&v"(t) : "s"(wv)); return t; }

__device__ __forceinline__ int inproj_src_col(int t, int p) {
    const int lc = 64 * ((p >> 5) & 3) + 32 * (p >> 7) + (p & 31);
    if (t <= 1) return 256 * t + lc;
    if (t == 2) return lc < 128 ? 512 + lc : 640 + (lc - 128);
    if (t == 3) return 768 + lc;
    if (t == 4) return lc < 64 ? 1024 + lc : (lc < 68 ? 1088 + (lc - 64) : -1);
    if (t <= 6) return 1092 + 256 * (t - 5) + lc;
    if (t <= 8) return 1604 + 256 * (t - 7) + lc;
    if (t <= 10) return 2116 + 256 * (t - 9) + lc;
    if (t <= 12) return 2628 + 256 * (t - 11) + lc;
    if (t <= 14) return 3140 + 256 * (t - 13) + lc;
    const int ct = t - 15, which = (lc >> 5) & 1, chn = 128 * ct + 32 * (lc >> 6) + (lc & 31);
    return (which ? 4164 : 3652) + chn;
}
__device__ __forceinline__ void cvt_item(const float* W, int ldw, int src, const float* gain, bf16* out, int K, int n0, int k0, LAS float* scr, int lane) {
    float v[32];
#pragma unroll
    for (int i = 0; i < 32; ++i) { const int kk = 2 * i + (lane >> 5); v[i] = (src >= 0) ? W[(size_t)(k0 + kk) * ldw + src] : 0.f; }
    if (gain) {
#pragma unroll
        for (int i = 0; i < 32; ++i) v[i] *= gain[k0 + 2 * i + (lane >> 5)];
    }
#pragma unroll
    for (int i = 0; i < 32; ++i) scr[(2 * i + (lane >> 5)) * 33 + (lane & 31)] = v[i];
    LDS_WAIT();
    const int c = lane & 7;
#pragma unroll
    for (int j = 0; j < 4; ++j) { const int n = (lane >> 3) + 8 * j; const LAS float* s = scr + (8 * c) * 33 + n;
        v4u o; o.x = pk2(s[0 * 33], s[1 * 33]); o.y = pk2(s[2 * 33], s[3 * 33]); o.z = pk2(s[4 * 33], s[5 * 33]); o.w = pk2(s[6 * 33], s[7 * 33]);
        *(v4u*)(out + (size_t)(n0 + n) * K + k0 + 8 * c) = o; }
    LDS_WAIT();
}
__device__ __forceinline__ void phase_prologue(ArgsP a, LAS unsigned char* lds, int G, int bid, int wv) {
    const int tid = opaque_tid(wv), lane = tid & 63, wave = tid >> 6;
    LAS float* scr = (LAS float*)(lds + wave * 16384);
    const int gw = bid * NWAVES + wave, NGW = G * NWAVES;
    unsigned char* ws = a->ws;
    constexpr int I0 = 16 * 152, I1 = 16 * 96, I2 = 8 * 32, I5 = 16 * 32, I6 = 16 * 128, I7 = 64 * 32;
    constexpr int ILAYER = I0 + I1 + 3 * I2 + I5 + I6 + I7;
    for (int it = gw; it < NLAYER * ILAYER; it += NGW) {
        const int l = it / ILAYER; int r = it % ILAYER;
        unsigned char* wl = ws + WS_W + (size_t)l * W_LAYER;
        const float* win = a->in[4] + (size_t)l * 1024 * DIN;
        if (r < I0) { const int kb = r / 152, nb = r % 152, n = nb * 32 + (lane & 31);
            cvt_item(win, DIN, inproj_src_col(n >> 8, n & 255), a->in[3] + l * 1024, (bf16*)(wl + W_IN), 1024, nb * 32, kb * 64, scr, lane); continue; } r -= I0;
        if (r < I1) { const int kb = r / 96, nb = r % 96;
            cvt_item(win, DIN, 4676 + nb * 32 + (lane & 31), a->in[3] + l * 1024, (bf16*)(wl + W_G), 1024, nb * 32, kb * 64, scr, lane); continue; } r -= I1;
        if (r < 3 * I2) { const int which = r / I2; r %= I2; const int kb = r / 32, nb = r % 32;
            cvt_item(a->in[9 + which] + (size_t)l * 512 * 1024, 1024, nb * 32 + (lane & 31), nullptr, (bf16*)(wl + W_UA + which * MiB), 512, nb * 32, kb * 64, scr, lane); continue; } r -= 3 * I2;
        if (r < I5) { const int kb = r / 32, nb = r % 32;
            cvt_item(a->in[12] + (size_t)l * 1024 * 1024, 1024, nb * 32 + (lane & 31), nullptr, (bf16*)(wl + W_O), 1024, nb * 32, kb * 64, scr, lane); continue; } r -= I5;
        if (r < I6) { const int kb = r / 128, nb = r % 128;
            cvt_item(a->in[14] + (size_t)l * 1024 * 4096, 4096, nb * 32 + (lane & 31), a->in[13] + l * 1024, (bf16*)(wl + W_UP), 1024, nb * 32, kb * 64, scr, lane); continue; } r -= I6;
        { const int kb = r / 32, nb = r % 32;
            cvt_item(a->in[15] + (size_t)l * 4096 * 1024, 1024, nb * 32 + (lane & 31), nullptr, (bf16*)(wl + W_DN), 4096, nb * 32, kb * 64, scr, lane); }
    }
    u64* ssq = (u64*)(ws + WS_SSQ);
    bf16* XB = (bf16*)(ws + WS_XB);
    for (int m0 = gw * 4; m0 < MTOK; m0 += NGW * 4) {
        f32x4 v[4][4];
#pragma unroll
        for (int rr = 0; rr < 4; ++rr) { const f32x4* xr = (const f32x4*)(a->in[0] + (size_t)(m0 + rr) * DM) + lane;
#pragma unroll
            for (int j = 0; j < 4; ++j) v[rr][j] = xr[64 * j]; }
#pragma unroll
        for (int rr = 0; rr < 4; ++rr) { const int m = m0 + rr; float s = 0.f;
#pragma unroll
            for (int j = 0; j < 4; ++j) s += (v[rr][j][0] * v[rr][j][0] + v[rr][j][1] * v[rr][j][1]) + (v[rr][j][2] * v[rr][j][2] + v[rr][j][3] * v[rr][j][3]);
            s = wave_sum(s, lane);
            v2u* o8 = (v2u*)(XB + (size_t)m * DM) + lane;
#pragma unroll
            for (int j = 0; j < 4; ++j) { v2u w; w.x = pk2(v[rr][j][0], v[rr][j][1]); w.y = pk2(v[rr][j][2], v[rr][j][3]); o8[64 * j] = w; }
            if (lane == 0) { ssq[m] = (u64)(s * 65536.0f + 0.5f); ssq[MTOK + m] = 0ull; ssq[2 * MTOK + m] = 0ull; ssq[3 * MTOK + m] = 0ull; } }
    }
    float* lb = (float*)(ws + WS_LB);
    for (int c = bid * NTHREADS + tid; c < 512; c += G * NTHREADS) { lb[c] = 0.f; lb[512 + c] = sigmoidf_(a->in[2][512 + c] - a->in[2][c]); }
}

__device__ __forceinline__ int wave_incl_scan(int x) {
    x += __builtin_amdgcn_update_dpp(0, x, 0x111, 0xf, 0xf, false);
    x += __builtin_amdgcn_update_dpp(0, x, 0x112, 0xf, 0xf, false);
    x += __builtin_amdgcn_update_dpp(0, x, 0x114, 0xf, 0xf, false);
    x += __builtin_amdgcn_update_dpp(0, x, 0x118, 0xf, 0xf, false);
    x += __builtin_amdgcn_update_dpp(0, x, 0x142, 0xa, 0xf, false);
    x += __builtin_amdgcn_update_dpp(0, x, 0x143, 0xc, 0xf, false);
    return x;
}
__device__ __forceinline__ int wave_suffix_sum(int s) { const int p = wave_incl_scan(s); return __builtin_amdgcn_readlane(p, 63) - p + s; }
constexpr int IDX_CAP = 1024;
__device__ __forceinline__ int select_top256(LAS int* buf, int n, LAS unsigned* hist, int lane) {
    int e[16];
#pragma unroll
    for (int i = 0; i < 16; ++i) e[i] = (lane + 64 * i < n) ? buf[lane + 64 * i] : (int)0x80000000;
    unsigned prefix = 0; int need = 256;
#pragma unroll 1
    for (int round = 0; round < 4; ++round) {
        const int shift = 24 - 8 * round;
        *(LAS v4u*)(hist + 4 * lane) = (v4u){0u, 0u, 0u, 0u};
        LDS_WAIT();
#pragma unroll
        for (int i = 0; i < 16; ++i) { const unsigned uu = (unsigned)e[i] ^ 0x80000000u;
            const bool match = (lane + 64 * i < n) && (round == 0 || (uu >> (shift + 8)) == prefix);
            if (match) __hip_atomic_fetch_add(hist + ((uu >> shift) & 255u), 1u, __ATOMIC_RELAXED, __HIP_MEMORY_SCOPE_WORKGROUP); }
        LDS_WAIT();
        const v4u h4 = *(LAS v4u*)(hist + 4 * lane);
        LDS_WAIT();
        const int s = (int)(h4.x + h4.y + h4.z + h4.w);
        const int S = wave_suffix_sum(s);
        const unsigned long long bal = __ballot(S >= need);
        const int L = __builtin_amdgcn_readfirstlane(63 - __builtin_clzll(bal | 1ull));
        const int SL = __builtin_amdgcn_readlane(S, L), hx = __builtin_amdgcn_readlane((int)h4.x, L), hy = __builtin_amdgcn_readlane((int)h4.y, L), hz = __builtin_amdgcn_readlane((int)h4.z, L), hw = __builtin_amdgcn_readlane((int)h4.w, L);
        const int above = SL - (hx + hy + hz + hw);
        int b;
        const int c3 = above + hw, c2 = c3 + hz, c1 = c2 + hy;
        if (c3 >= need) { b = 4 * L + 3; need -= above; }
        else if (c2 >= need) { b = 4 * L + 2; need -= c3; }
        else if (c1 >= need) { b = 4 * L + 1; need -= c2; }
        else { b = 4 * L; need -= c1; }
        prefix = (prefix << 8) | (unsigned)b;
    }
    int base = 0;
#pragma unroll
    for (int i = 0; i < 16; ++i) { const bool keep = (lane + 64 * i < n) && (((unsigned)e[i] ^ 0x80000000u) >= prefix);
        const unsigned long long bal = __ballot(keep);
        const int pos = base + __popcll(bal & ((1ull << lane) - 1ull));
        if (keep) buf[pos] = e[i];
        base += __popcll(bal); }
    LDS_WAIT();
    return (int)(prefix ^ 0x80000000u);
}

__device__ __forceinline__ void emit_selected(LAS int* kb, int n, LAS unsigned* bm, unsigned short* dst, int lane) {
    int pos[4];
#pragma unroll
    for (int i = 0; i < 4; ++i) { const int k = lane + 64 * i; pos[i] = (k < n) ? (int)(8191u - ((unsigned)kb[k] & 0x1fffu)) : -1; }
    *(LAS v4u*)(bm + 4 * lane) = (v4u){0u, 0u, 0u, 0u};
    LDS_WAIT();
#pragma unroll
    for (int i = 0; i < 4; ++i) if (pos[i] >= 0) __hip_atomic_fetch_or(bm + (pos[i] >> 5), 1u << (pos[i] & 31), __ATOMIC_RELAXED, __HIP_MEMORY_SCOPE_WORKGROUP);
    LDS_WAIT();
    const v4u w = *(const LAS v4u*)(bm + 4 * lane);
    const int c0 = __popc(w.x), c1 = __popc(w.y), c2 = __popc(w.z), c = c0 + c1 + c2 + __popc(w.w);
    const int incl = wave_incl_scan(c);
    const unsigned o = (unsigned)(incl - c);
    LAS unsigned* pre = (LAS unsigned*)kb;
    *(LAS v4u*)(pre + 4 * lane) = (v4u){o, o + (unsigned)c0, o + (unsigned)(c0 + c1), o + (unsigned)(c0 + c1 + c2)};
    LDS_WAIT();
#pragma unroll
    for (int i = 0; i < 4; ++i) { const int k = lane + 64 * i;
        if (pos[i] >= 0) { const int wd = pos[i] >> 5; const unsigned rank = pre[wd] + (unsigned)__popc(bm[wd] & ((1u << (pos[i] & 31)) - 1u)); dst[rank] = (unsigned short)pos[i]; }
        if (k >= n) dst[k] = (unsigned short)0; }
    LDS_WAIT();
}
__device__ __forceinline__ void indexer_group_slow(LAS unsigned char* lds, const bf16* TIQ, const bf16* TIK, const float* TIW, unsigned short* SEL, int b, int qg, int wv) {
    const int tid = opaque_tid(wv), lane = tid & 63, wave = __builtin_amdgcn_readfirstlane(tid >> 6);
    LAS int* buf = (LAS int*)lds;
    LAS int* cnt = (LAS int*)(lds + LDS_AUX);
    LAS int* thr = cnt + 32;
    LAS int* flg = cnt + 64;
    LAS unsigned* hist = (LAS unsigned*)(lds + LDS_AUX + 1024) + wave * 256;
    const int j = lane & 31, hh = lane >> 5;
    const int t0 = qg * 32, nt = qg + 1;
    const size_t rowbase = (size_t)b * SEQ;
    if (tid < 32) { cnt[tid] = 0; thr[tid] = (int)0x80000000; flg[tid & 1] = 0; }
    bf16x8 bq[4][4];
    {   const bf16* qp = TIQ + (rowbase + t0 + j) * 256 + hh * 8;
#pragma unroll
        for (int h = 0; h < 4; ++h)
#pragma unroll
            for (int ks = 0; ks < 4; ++ks) bq[h][ks] = *(const bf16x8*)(qp + h * 64 + ks * 16); }
    const f32x4 wgt = *(const f32x4*)(TIW + (rowbase + t0 + j) * 4);
    __syncthreads();
    LAS int* mybuf = buf + j * IDX_CAP;
    for (int it = 0; it * 8 < nt; ++it) {
        const int tile = it * 8 + wave;
        if (tile < nt) {
            const bf16* kp = TIK + (rowbase + tile * 32 + j) * 64 + hh * 8;
            bf16x8 ka[4];
#pragma unroll
            for (int ks = 0; ks < 4; ++ks) ka[ks] = *(const bf16x8*)(kp + ks * 16);
            f32x16 acc[4];
#pragma unroll
            for (int h = 0; h < 4; ++h) {
#pragma unroll
                for (int r = 0; r < 16; ++r) acc[h][r] = 0.f;
#pragma unroll
                for (int ks = 0; ks < 4; ++ks) acc[h] = __builtin_amdgcn_mfma_f32_32x32x16_bf16(ka[ks], bq[h][ks], acc[h], 0, 0, 0);
            }
            const int th = thr[j];
            const int tq = t0 + j;
            int keys[16]; unsigned mask = 0u;
#pragma unroll
            for (int r = 0; r < 16; ++r) {
                const int s = tile * 32 + 8 * (r >> 2) + 4 * hh + (r & 3);
                const float sc = __builtin_fmaf(wgt[3], __int_as_float(max(__float_as_int(acc[3][r]), 0)), __builtin_fmaf(wgt[2], __int_as_float(max(__float_as_int(acc[2][r]), 0)),
                                  __builtin_fmaf(wgt[1], __int_as_float(max(__float_as_int(acc[1][r]), 0)), wgt[0] * __int_as_float(max(__float_as_int(acc[0][r]), 0)))));
                const int si = __float_as_int(sc);
                const int o = si ^ ((si >> 31) & 0x7fffffff);
                const int key = (o & ~0x1fff) | (8191 - s);
                keys[r] = key;
                if (s <= tq && key > th) mask |= (1u << r);
            }
            if (mask) {
                int pos = __hip_atomic_fetch_add(cnt + j, __popc(mask), __ATOMIC_RELAXED, __HIP_MEMORY_SCOPE_WORKGROUP);
#pragma unroll
                for (int r = 0; r < 16; ++r) if (mask & (1u << r)) { mybuf[pos] = keys[r]; ++pos; }
            }
        }
        __syncthreads();
        if (tid < 32 && cnt[tid] > IDX_CAP - 256) flg[it & 1] = 1;
        if (tid == 0) flg[(it + 1) & 1] = 0;
        __syncthreads();
        if (flg[it & 1]) {
            for (int q = wave; q < 32; q += 8) { const int n = cnt[q];
                if (n > 512) { const int tnew = select_top256(buf + q * IDX_CAP, n, hist, lane); if (lane == 0) { cnt[q] = 256; thr[q] = tnew; } } }
            __syncthreads();
        }
    }
    for (int q = wave; q < 32; q += 8) {
        int n = cnt[q];
        if (n > 256) { (void)select_top256(buf + q * IDX_CAP, n, hist, lane); n = 256; }
        emit_selected(buf + q * IDX_CAP, n, hist, SEL + (rowbase + t0 + q) * 256, lane);
    }
    __syncthreads();
}
typedef float f32x2v __attribute__((ext_vector_type(2)));
template <int PASS>
__device__ __forceinline__ void idx_pass(const bf16* TIK, size_t rowbase, int t0, int nt, int wave, int j, int hh, const bf16x8 (&bq)[4][4], const f32x4 wgt,
                                         LAS unsigned* hist, LAS int* buf, LAS int* cnt, int thr) {
    bf16x8 ka[4];
    int tile = wave;
    if (tile < nt) { const bf16* kp = TIK + (rowbase + tile * 32 + j) * 64 + hh * 8;
#pragma unroll
        for (int ks = 0; ks < 4; ++ks) ka[ks] = *(const bf16x8*)(kp + ks * 16); }
    const int tq = t0 + j;
    const int hbase = j * 4096 + 2048;
    LAS int* mybuf = buf + j * IDX_CAP;
    const f32x2v w0 = (f32x2v){wgt[0], wgt[0]}, w1 = (f32x2v){wgt[1], wgt[1]}, w2 = (f32x2v){wgt[2], wgt[2]}, w3 = (f32x2v){wgt[3], wgt[3]};
#pragma unroll 1
    for (; tile < nt; tile += 8) {
        f32x16 acc[4];
#pragma unroll
        for (int h = 0; h < 4; ++h) {
#pragma unroll
            for (int r = 0; r < 16; ++r) acc[h][r] = 0.f;
#pragma unroll
            for (int ks = 0; ks < 4; ++ks) acc[h] = __builtin_amdgcn_mfma_f32_32x32x16_bf16(ka[ks], bq[h][ks], acc[h], 0, 0, 0);
        }
        if (tile + 8 < nt) { const bf16* kp = TIK + (rowbase + (tile + 8) * 32 + j) * 64 + hh * 8;
#pragma unroll
            for (int ks = 0; ks < 4; ++ks) ka[ks] = *(const bf16x8*)(kp + ks * 16); }
        const int lowb = 8191 - tile * 32 - 4 * hh;
        const int lim = tq - tile * 32 - 4 * hh;
        unsigned mask = 0u;
#pragma unroll
        for (int r2 = 0; r2 < 8; ++r2) {
            const int ra = 2 * r2, rb = 2 * r2 + 1;
#define IDX_RELU(x_) __int_as_float(max(__float_as_int(x_), 0))
            f32x2v sc;
            {   float r0 = IDX_RELU(acc[0][ra]), r1 = IDX_RELU(acc[1][ra]), r2 = IDX_RELU(acc[2][ra]), r3 = IDX_RELU(acc[3][ra]), t;
                asm("v_mul_f32 %0, %1, %2" : "=v"(t) : "v"(wgt[0]), "v"(r0)); asm("v_fmac_f32 %0, %1, %2" : "+v"(t) : "v"(wgt[1]), "v"(r1));
                asm("v_fmac_f32 %0, %1, %2" : "+v"(t) : "v"(wgt[2]), "v"(r2)); asm("v_fmac_f32 %0, %1, %2" : "+v"(t) : "v"(wgt[3]), "v"(r3)); sc.x = t; }
            {   float r0 = IDX_RELU(acc[0][rb]), r1 = IDX_RELU(acc[1][rb]), r2 = IDX_RELU(acc[2][rb]), r3 = IDX_RELU(acc[3][rb]), t;
                asm("v_mul_f32 %0, %1, %2" : "=v"(t) : "v"(wgt[0]), "v"(r0)); asm("v_fmac_f32 %0, %1, %2" : "+v"(t) : "v"(wgt[1]), "v"(r1));
                asm("v_fmac_f32 %0, %1, %2" : "+v"(t) : "v"(wgt[2]), "v"(r2)); asm("v_fmac_f32 %0, %1, %2" : "+v"(t) : "v"(wgt[3]), "v"(r3)); sc.y = t; }
#undef IDX_RELU
#pragma unroll
            for (int e = 0; e < 2; ++e) { const int r = 2 * r2 + e; const int ro = 8 * (r >> 2) + (r & 3);
                const int si = __float_as_int(e ? sc.y : sc.x);
                const int o = si ^ ((si >> 31) & 0x7fffffff);
                const int key = (o & ~0x1fff) | (lowb - ro);
                if (PASS == 1) { const unsigned val = (ro <= lim) ? (unsigned)__builtin_amdgcn_ubfe(o, 21, 1) * 0xffffu + 1u : 0u;
                    __hip_atomic_fetch_add((LAS unsigned*)((LAS unsigned char*)hist + hbase + (__builtin_amdgcn_sbfe(o, 22, 10) << 2)), val, __ATOMIC_RELAXED, __HIP_MEMORY_SCOPE_WORKGROUP); }
                else { acc[0][r] = __int_as_float(key); if (ro <= lim && key >= thr) mask |= (1u << r); } }
        }
        if (PASS == 2 && mask) {
            int pos = __hip_atomic_fetch_add(cnt + j, __popc(mask), __ATOMIC_RELAXED, __HIP_MEMORY_SCOPE_WORKGROUP);
#pragma unroll
            for (int r = 0; r < 16; ++r) if (mask & (1u << r)) { if (pos < IDX_CAP) mybuf[pos] = __float_as_int(acc[0][r]); ++pos; }
        }
    }
}
__device__ __forceinline__ int idx_find_bin(const LAS unsigned* hq, int lane, int& ncand) {
    v4u w[4];
#pragma unroll
    for (int i = 0; i < 4; ++i) w[i] = *(const LAS v4u*)(hq + 16 * lane + 4 * i);
    int s = 0;
#pragma unroll
    for (int i = 0; i < 4; ++i)
#pragma unroll
        for (int c = 0; c < 4; ++c) s += (int)(w[i][c] & 0xffffu) + (int)(w[i][c] >> 16);
    const int S = wave_suffix_sum(s);
    const int total = __builtin_amdgcn_readlane(S, 0);
    const unsigned long long bal = __ballot(S >= 256);
    const int L = __builtin_amdgcn_readfirstlane(63 - __builtin_clzll(bal | 1ull));
    int cum = S - s, rbin = 0, rcand = 0; bool found = false;
#pragma unroll
    for (int bb = 31; bb >= 0; --bb) { const int c = (int)((w[bb >> 3][(bb >> 1) & 3] >> (16 * (bb & 1))) & 0xffffu);
        cum += c; if (!found && cum >= 256) { found = true; rbin = 32 * lane + bb; rcand = cum; } }
    rbin = __builtin_amdgcn_readlane(rbin, L); rcand = __builtin_amdgcn_readlane(rcand, L);
    if (total <= 256) { ncand = total; return 0; }
    ncand = rcand; return rbin;
}
__device__ __forceinline__ void select_in_bin(LAS int* buf, int n_in, int binkey, LAS unsigned* hist, int lane) {
    const int n = __builtin_amdgcn_readfirstlane(n_in);
    int e[16]; int cab = 0;
#pragma unroll
    for (int i = 0; i < 16; ++i) { e[i] = (int)0x80000000; if (64 * i < n) { e[i] = (lane + 64 * i < n) ? buf[lane + 64 * i] : (int)0x80000000; cab += __popcll(__ballot((lane + 64 * i < n) && (e[i] >> 21) > binkey)); } }
    int need = 256 - cab; unsigned prefix = 0u;
#pragma unroll 1
    for (int round = 0; round < 3; ++round) {
        const int shift = 14 - 7 * round;
        if (lane < 32) *(LAS v4u*)(hist + 4 * lane) = (v4u){0u, 0u, 0u, 0u};
        LDS_WAIT();
#pragma unroll
        for (int i = 0; i < 16; ++i) if (64 * i < n) { const unsigned lowv = (unsigned)e[i] & 0x1fffffu;
            const bool match = ((e[i] >> 21) == binkey) && (lane + 64 * i < n) && (round == 0 || (lowv >> (shift + 7)) == prefix);
            if (match) __hip_atomic_fetch_add(hist + ((lowv >> shift) & 127u), 1u, __ATOMIC_RELAXED, __HIP_MEMORY_SCOPE_WORKGROUP); }
        LDS_WAIT();
        v4u h4 = (v4u){0u, 0u, 0u, 0u};
        if (lane < 32) h4 = *(LAS v4u*)(hist + 4 * lane);
        LDS_WAIT();
        const int s = (int)(h4.x + h4.y + h4.z + h4.w);
        const int S = wave_suffix_sum(s);
        const unsigned long long bal = __ballot(S >= need);
        const int L = __builtin_amdgcn_readfirstlane(63 - __builtin_clzll(bal | 1ull));
        const int SL = __builtin_amdgcn_readlane(S, L), hx = __builtin_amdgcn_readlane((int)h4.x, L), hy = __builtin_amdgcn_readlane((int)h4.y, L), hz = __builtin_amdgcn_readlane((int)h4.z, L), hw = __builtin_amdgcn_readlane((int)h4.w, L);
        const int above = SL - (hx + hy + hz + hw);
        int bsel; const int c3 = above + hw, c2 = c3 + hz, c1 = c2 + hy;
        if (c3 >= need) { bsel = 4 * L + 3; need -= above; }
        else if (c2 >= need) { bsel = 4 * L + 2; need -= c3; }
        else if (c1 >= need) { bsel = 4 * L + 1; need -= c2; }
        else { bsel = 4 * L; need -= c1; }
        prefix = (prefix << 7) | (unsigned)bsel;
    }
    int base = 0;
#pragma unroll
    for (int i = 0; i < 16; ++i) if (64 * i < n) { const int hb = e[i] >> 21; const bool keep = (lane + 64 * i < n) && (hb > binkey || (hb == binkey && ((unsigned)e[i] & 0x1fffffu) >= prefix));
        const unsigned long long bal = __ballot(keep);
        const int pos = base + __popcll(bal & ((1ull << lane) - 1ull));
        if (keep) buf[pos] = e[i];
        base += __popcll(bal); }
    LDS_WAIT();
}
__device__ __forceinline__ bool indexer_group(LAS unsigned char* lds, const bf16* TIQ, const bf16* TIK, const float* TIW, unsigned short* SEL, int b, int qg, int wv) {
    const int tid = opaque_tid(wv), lane = tid & 63, wave = __builtin_amdgcn_readfirstlane(tid >> 6);
    LAS unsigned* hist = (LAS unsigned*)lds;
    LAS int* buf = (LAS int*)lds;
    LAS int* cnt = (LAS int*)(lds + LDS_AUX);
    LAS int* thrq = cnt + 32;
    LAS int* fbk = cnt + 66;
    LAS unsigned* shist = (LAS unsigned*)(lds + LDS_AUX + 1024) + wave * 256;
    const int j = lane & 31, hh = lane >> 5;
    const int t0 = qg * 32, nt = qg + 1;
    const size_t rowbase = (size_t)b * SEQ;
#pragma unroll
    for (int i = 0; i < 16; ++i) *(LAS v4u*)(lds + (size_t)(tid + NTHREADS * i) * 16) = (v4u){0u, 0u, 0u, 0u};
    if (tid < 32) cnt[tid] = 0;
    if (tid == 0) fbk[0] = 0;
    bf16x8 bq[4][4];
    {   const bf16* qp = TIQ + (rowbase + t0 + j) * 256 + hh * 8;
#pragma unroll
        for (int h = 0; h < 4; ++h)
#pragma unroll
            for (int ks = 0; ks < 4; ++ks) bq[h][ks] = *(const bf16x8*)(qp + h * 64 + ks * 16); }
    const f32x4 wgt = *(const f32x4*)(TIW + (rowbase + t0 + j) * 4);
    __syncthreads();
    idx_pass<1>(TIK, rowbase, t0, nt, wave, j, hh, bq, wgt, hist, buf, cnt, 0);
    __syncthreads();
    for (int q = wave; q < 32; q += 8) { int ncand; const int bin = idx_find_bin(hist + q * 1024, lane, ncand);
        if (lane == 0) { thrq[q] = (bin == 0) ? (int)0x80000000 : (int)((unsigned)(bin - 1024) << 21); if (ncand > IDX_CAP) fbk[0] = 1; } }
    __syncthreads();
    if (fbk[0]) { __syncthreads(); return true; }
    idx_pass<2>(TIK, rowbase, t0, nt, wave, j, hh, bq, wgt, hist, buf, cnt, thrq[j]);
    __syncthreads();
    for (int q = wave; q < 32; q += 8) {
        int n = cnt[q]; n = n < IDX_CAP ? n : IDX_CAP;
        if (n > 256) { select_in_bin(buf + q * IDX_CAP, n, thrq[q] >> 21, shist, lane); n = 256; }
        emit_selected(buf + q * IDX_CAP, n, shist, SEL + (rowbase + t0 + q) * 256, lane);
    }
    __syncthreads();
    return false;
}
__device__ __forceinline__ void phase_indexer(ArgsP a, LAS unsigned char* lds, int l, int G, int bid, int wv) {
    unsigned char* ws = a->ws;
    const bf16* TIQ = (const bf16*)(ws + A_TIQ); const bf16* TIK = (const bf16*)(ws + A_TIK); const float* TIW = (const float*)(ws + A_TIW); unsigned short* SEL = (unsigned short*)(ws + A_SEL);
    const int b = bid & 7;
    unsigned* ticket = (unsigned*)(ws + WS_CTL) + CW_TICKET + (32 + l * 8 + b) * 64;
    volatile LAS int* tks = (volatile LAS int*)(lds + MISC_OFF + 128);
    const int tid0 = opaque_tid(wv);
#pragma unroll 1
    for (;;) {
        if (tid0 == 0) tks[0] = (int)__hip_atomic_fetch_add(ticket, 1u, __ATOMIC_RELAXED, __HIP_MEMORY_SCOPE_AGENT);
        __syncthreads();
        const int tk = __builtin_amdgcn_readfirstlane(tks[0]);
        __syncthreads();
        if (tk >= SEQ / 32) break;
        const int qg = SEQ / 32 - 1 - tk;
        const bool slow = indexer_group(lds, TIQ, TIK, TIW, SEL, b, qg, wv);
        if (slow) indexer_group_slow(lds, TIQ, TIK, TIW, SEL, b, qg, wv);
    }
}

constexpr int HPRP = 272;
constexpr int HPO_LF = 0, HPO_Q = 17408, HPO_I = 34816, HPO_TOT = 52224, HPO_QD = 54272, HPO_QX = HPO_QD + 64 * HPRP, HPO_KB = HPO_QX + 48 * HPRP, HPO_KD = HPO_KB + 48 * HPRP;
__device__ __forceinline__ void phase_hgrn_pre(ArgsP a, LAS unsigned char* lds, int G, int bid, int wv) {
    unsigned char* ws = a->ws;
    bf16* THQ = (bf16*)(ws + A_THQ); bf16* THF = (bf16*)(ws + A_THF); bf16* THI = (bf16*)(ws + A_THI); bf16* HATTN = (bf16*)(ws + A_HATTN); float* HDEC = (float*)(ws + A_HDEC);
    const int tid = opaque_tid(wv), lane = tid & 63, wave = tid >> 6, fr = lane & 15, fq = lane >> 4;
    const int sa = tid >> 7, d = tid & 127;
    LAS float* sTot = (LAS float*)(lds + HPO_TOT);
    constexpr int NU = (MTOK / 64) * 4;
    v4u ld[6];
#define HP_LOAD(u_) do { const int h_ = (u_) & 3; const size_t r0_ = (size_t)((u_) >> 2) * 64; _Pragma("unroll") for (int i_ = 0; i_ < 2; ++i_) { const int p_ = tid + NTHREADS * i_; \
        const size_t o_ = (r0_ + (p_ >> 4)) * 512 + h_ * 128 + (p_ & 15) * 8; ld[i_] = *(const v4u*)(THF + o_); ld[2 + i_] = *(const v4u*)(THQ + o_); ld[4 + i_] = *(const v4u*)(THI + o_); } } while (0)
    if (bid < NU) HP_LOAD(bid);
#pragma unroll 1
    for (int u = bid; u < NU; u += G) {
        const int h = u & 3; const size_t row0 = (size_t)(u >> 2) * 64;
#pragma unroll
        for (int i = 0; i < 2; ++i) { const int p = tid + NTHREADS * i, o = (p >> 4) * HPRP + (p & 15) * 16;
            *(LAS v4u*)(lds + HPO_LF + o) = ld[i]; *(LAS v4u*)(lds + HPO_Q + o) = ld[2 + i]; *(LAS v4u*)(lds + HPO_I + o) = ld[4 + i]; }
        __syncthreads();
        if (u + G < NU) HP_LOAD(u + G);
        float lf[16], qv[16], iv[16], gl[16];
#pragma unroll
        for (int i = 0; i < 16; ++i) { const int o = (sa * 16 + i) * HPRP + d * 2;
            lf[i] = bf2f(*(const LAS unsigned short*)(lds + HPO_LF + o)); qv[i] = bf2f(*(const LAS unsigned short*)(lds + HPO_Q + o)); iv[i] = bf2f(*(const LAS unsigned short*)(lds + HPO_I + o)); }
        { float g = 0.f;
#pragma unroll
          for (int i = 0; i < 16; ++i) { g += lf[i]; gl[i] = g; } }
        sTot[sa * 128 + d] = gl[15];
        __syncthreads();
        const float t0 = sTot[d], t1 = sTot[128 + d], t2 = sTot[256 + d], t3 = sTot[384 + d];
        const float pre = (sa > 0 ? t0 : 0.f) + (sa > 1 ? t1 : 0.f) + (sa > 2 ? t2 : 0.f);
        const float tsa = sa == 0 ? t0 : sa == 1 ? t1 : sa == 2 ? t2 : t3;
        const float glast = (t0 + t1) + (t2 + t3);
        const float cpre = __expf(pre);
        const float cr1 = __expf(sa == 2 ? t1 : t1 + t2);
        const float cr2 = __expf(t2);
        const float ctail = __expf(glast - (pre + tsa));
        float kt[16];
#pragma unroll
        for (int i = 0; i < 16; ++i) { const int t = sa * 16 + i, o = t * HPRP + d * 2; const float gi = gl[i];
            const float E = __expf(gi), Dc = __expf(fminf(-gi, 80.f)), Kb = __expf(tsa - gi), kk = 1.0f - __expf(lf[i]);
            const float qd = qv[i] * E;
            *(LAS unsigned short*)(lds + HPO_QD + o) = (unsigned short)f2bf(qd);
            if (sa == 2) *(LAS unsigned short*)(lds + HPO_QX + i * HPRP + d * 2) = (unsigned short)f2bf(qd * cr1);
            if (sa == 3) { *(LAS unsigned short*)(lds + HPO_QX + (16 + i) * HPRP + d * 2) = (unsigned short)f2bf(qd * cr1); *(LAS unsigned short*)(lds + HPO_QX + (32 + i) * HPRP + d * 2) = (unsigned short)f2bf(qd * cr2); }
            *(LAS unsigned short*)(lds + HPO_Q + o) = (unsigned short)f2bf(qd * cpre);
            *(LAS unsigned short*)(lds + HPO_KD + o) = (unsigned short)f2bf(kk * Dc);
            const float kb = kk * Kb;
            if (sa < 3) *(LAS unsigned short*)(lds + HPO_KB + o) = (unsigned short)f2bf(kb);
            kt[i] = kb * ctail; }
        {
            const size_t toff = (row0 + (d >> 1)) * 512 + h * 128 + (d & 1) * 64 + sa * 16;
            *(v4u*)(THF + toff) = pack8((f32x4){kt[0], kt[1], kt[2], kt[3]}, (f32x4){kt[4], kt[5], kt[6], kt[7]});
            *(v4u*)(THF + toff + 8) = pack8((f32x4){kt[8], kt[9], kt[10], kt[11]}, (f32x4){kt[12], kt[13], kt[14], kt[15]});
            *(v4u*)(THI + toff) = pack8((f32x4){iv[0], iv[1], iv[2], iv[3]}, (f32x4){iv[4], iv[5], iv[6], iv[7]});
            *(v4u*)(THI + toff + 8) = pack8((f32x4){iv[8], iv[9], iv[10], iv[11]}, (f32x4){iv[12], iv[13], iv[14], iv[15]}); }
        if (sa == 3) HDEC[(size_t)u * 128 + d] = __expf(glast);
        __syncthreads();
        bf16* at = HATTN + (size_t)u * 4096;
        for (int blk = wave; blk < 10; blk += 8) {
            const int ba = blk >= 6 ? 3 : blk >= 3 ? 2 : blk >= 1 ? 1 : 0, bb = blk - (ba * (ba + 1)) / 2;
            const int arow = (bb + 1 >= ba) ? HPO_QD + (16 * ba) * HPRP : HPO_QX + (ba == 2 ? 0 : 16 * (1 + bb)) * HPRP;
            const int brow = (bb == ba) ? HPO_KD + (16 * ba) * HPRP : HPO_KB + (16 * bb) * HPRP;
            f32x4 c = (f32x4){0.f, 0.f, 0.f, 0.f};
#pragma unroll
            for (int ks = 0; ks < 4; ++ks) { const bf16x8 A = *(const LAS bf16x8*)(lds + arow + fr * HPRP + (32 * ks + 8 * fq) * 2), B = *(const LAS bf16x8*)(lds + brow + fr * HPRP + (32 * ks + 8 * fq) * 2);
                c = __builtin_amdgcn_mfma_f32_16x16x32_bf16(A, B, c, 0, 0, 0); }
#pragma unroll
            for (int r = 0; r < 4; ++r) { const int tl = 4 * fq + r; const float v = (bb < ba || fr <= tl) ? c[r] : 0.f; at[(ba * 16 + tl) * 64 + bb * 16 + fr] = (bf16)f2bf(v); }
        }
        for (int e = tid; e < 6 * 256; e += NTHREADS) { const int z = e >> 8, za = z < 3 ? 0 : (z < 5 ? 1 : 2), zb = z < 3 ? z + 1 : (z < 5 ? z - 1 : 3);
            at[(za * 16 + ((e >> 4) & 15)) * 64 + zb * 16 + (e & 15)] = (bf16)0; }
#pragma unroll
        for (int i = 0; i < 2; ++i) { const int p = tid + NTHREADS * i; *(v4u*)(THQ + (row0 + (p >> 4)) * 512 + h * 128 + (p & 15) * 8) = *(const LAS v4u*)(lds + HPO_Q + (p >> 4) * HPRP + (p & 15) * 16); }
        __syncthreads();
    }
#undef HP_LOAD
}

__device__ __forceinline__ void phase_conv(ArgsP a, int l, int G, int bid, int wv) {
    unsigned char* ws = a->ws;
    bf16* TCB = (bf16*)(ws + A_TCB); const bf16* TU = (const bf16*)(ws + A_TU);
    const float* cw = a->in[8] + (size_t)l * 3 * 512;
    const int tid = opaque_tid(wv);
    const int c0 = (tid & 63) * 8;
    float w0[8], w1[8], w2[8];
#pragma unroll
    for (int j = 0; j < 8; ++j) { w0[j] = cw[c0 + j]; w1[j] = cw[512 + c0 + j]; w2[j] = cw[1024 + c0 + j]; }
    const int rstep = G * (NTHREADS / 64);
    v4u q2a[4], q1a[4], q0a[4], qba[4], q2b[4], q1b[4], q0b[4], qbb[4];
#define CONV_LOAD(q2_, q1_, q0_, qb_, r0_) do { _Pragma("unroll") for (int i = 0; i < 4; ++i) { const int row = (r0_) + i * rstep; const int t = row & (SEQ - 1); \
            if (row < MTOK) { const bf16* up = TU + (size_t)row * 512 + c0; \
                q2_[i] = *(const v4u*)up; qb_[i] = *(const v4u*)(TCB + (size_t)row * 512 + c0); \
                q1_[i] = (t >= 1) ? *(const v4u*)(up - 512) : (v4u){0u, 0u, 0u, 0u}; \
                q0_[i] = (t >= 2) ? *(const v4u*)(up - 1024) : (v4u){0u, 0u, 0u, 0u}; } } } while (0)
#define CONV_DO(q2_, q1_, q0_, qb_, r0_) do { _Pragma("unroll") for (int i = 0; i < 4; ++i) { const int row = (r0_) + i * rstep; \
            if (row < MTOK) { float u0[8], u1[8], u2[8], cb[8]; \
                unpack8(q2_[i], u2); unpack8(q1_[i], u1); unpack8(q0_[i], u0); unpack8(qb_[i], cb); \
                f32x4 ra, rb; \
                _Pragma("unroll") for (int j = 0; j < 8; ++j) { const float y = cb[j] * (w0[j] * u0[j] + w1[j] * u1[j] + w2[j] * u2[j]); if (j < 4) ra[j] = y; else rb[j - 4] = y; } \
                *(v4u*)(TCB + (size_t)row * 512 + c0) = pack8(ra, rb); } } } while (0)
    int r0 = bid * (NTHREADS / 64) + (tid >> 6);
    CONV_LOAD(q2a, q1a, q0a, qba, r0);
#pragma unroll 1
    for (; r0 < MTOK; r0 += 8 * rstep) {
        CONV_LOAD(q2b, q1b, q0b, qbb, r0 + 4 * rstep);
        CONV_DO(q2a, q1a, q0a, qba, r0);
        CONV_LOAD(q2a, q1a, q0a, qba, r0 + 8 * rstep);
        CONV_DO(q2b, q1b, q0b, qbb, r0 + 4 * rstep);
    }
#undef CONV_LOAD
#undef CONV_DO
}

__device__ __forceinline__ void hgrn_post_bh(const bf16* HO, bf16* THG, const float* gn, int b, int h, int tid) {
    const int lane = tid & 63, wave = tid >> 6, c8 = (lane & 15) * 8;
    float gv[8];
#pragma unroll
    for (int j = 0; j < 8; ++j) gv[j] = gn[c8 + j];
#pragma unroll 1
    for (int t0 = wave * 4 + (lane >> 4); t0 < SEQ; t0 += NWAVES * 4 * 8) {
        v4u ov[8], hv[8];
#pragma unroll
        for (int i = 0; i < 8; ++i) { const size_t off = ((size_t)b * SEQ + t0 + i * NWAVES * 4) * 512 + h * 128 + c8; ov[i] = *(const v4u*)(HO + off); hv[i] = *(const v4u*)(THG + off); }
#pragma unroll
        for (int i = 0; i < 8; ++i) { const size_t off = ((size_t)b * SEQ + t0 + i * NWAVES * 4) * 512 + h * 128 + c8;
            float o[8], hg[8];
            unpack8(ov[i], o); unpack8(hv[i], hg);
            float ss = 0.f;
#pragma unroll
            for (int j = 0; j < 8; ++j) ss += o[j] * o[j];
            ss += shx(ss, 1, lane); ss += shx(ss, 2, lane); ss += shx(ss, 4, lane); ss += shx(ss, 8, lane);
            const float r = rsqrtf(ss * (1.0f / 128.0f) + EPS);
            f32x4 r0, r1;
#pragma unroll
            for (int j = 0; j < 8; ++j) { const float y = o[j] * r * gv[j] * (hg[j] * sigmoidf_(hg[j])); if (j < 4) r0[j] = y; else r1[j - 4] = y; }
            *(v4u*)(THG + off) = pack8(r0, r1); }
    }
}
constexpr int HS_ATT = 0, HS_Q = 9216, HS_K = 26624, HS_DEC = 45056, HS_BUF = 45568;
__device__ __forceinline__ void phase_hgrn_seq(ArgsP a, LAS unsigned char* lds, int l, int G, int bid, int wv) {
    unsigned char* ws = a->ws;
    const bf16* THQ = (const bf16*)(ws + A_THQ); const bf16* THF = (const bf16*)(ws + A_THF); const bf16* THI = (const bf16*)(ws + A_THI);
    const bf16* HATTN = (const bf16*)(ws + A_HATTN); const float* HDEC = (const float*)(ws + A_HDEC); bf16* HO = (bf16*)(ws + A_HO);
    const int tid = opaque_tid(wv), lane = tid & 63, wave = __builtin_amdgcn_readfirstlane(tid >> 6), fr = lane & 15, fq = lane >> 4;
    constexpr int NCH = SEQ / 64;
    for (int u = bid; u < NBATCH * 4; u += G) {
        const int h = u & 3, b = u >> 2;
        const int vcol = 16 * wave + fr;
        f32x4 Sacc[8]; bf16x8 Sb[4];
#pragma unroll
        for (int i = 0; i < 8; ++i) Sacc[i] = (f32x4){0.f, 0.f, 0.f, 0.f};
#pragma unroll
        for (int i = 0; i < 4; ++i) Sb[i] = (bf16x8){0, 0, 0, 0, 0, 0, 0, 0};
        v4u st[5]; float stdec = 0.f; bf16x8 bi[2], bin[2];
#define HS_LOAD(c_) do { const size_t row0_ = (size_t)b * SEQ + (size_t)(c_) * 64; const size_t cu_ = ((size_t)b * NCH + (c_)) * 4 + h; \
            st[0] = *(const v4u*)(HATTN + cu_ * 4096 + (size_t)tid * 8); \
            _Pragma("unroll") for (int i_ = 0; i_ < 2; ++i_) { const int p_ = tid + 512 * i_; \
                st[1 + i_] = *(const v4u*)(THQ + (row0_ + (p_ >> 4)) * 512 + h * 128 + (p_ & 15) * 8); \
                const int d_ = p_ >> 3; st[3 + i_] = *(const v4u*)(THF + (row0_ + (d_ >> 1)) * 512 + h * 128 + (d_ & 1) * 64 + (p_ & 7) * 8); } \
            if (tid < 128) stdec = HDEC[cu_ * 128 + tid]; } while (0)
#define HS_WRITE(buf_) do { LAS unsigned char* q_ = lds + (buf_) * HS_BUF; \
            *(LAS v4u*)(q_ + HS_ATT + (tid >> 3) * 144 + (tid & 7) * 16) = st[0]; \
            _Pragma("unroll") for (int i_ = 0; i_ < 2; ++i_) { const int p_ = tid + 512 * i_; \
                *(LAS v4u*)(q_ + HS_Q + (p_ >> 4) * 272 + (p_ & 15) * 16) = st[1 + i_]; \
                *(LAS v4u*)(q_ + HS_K + (p_ >> 3) * 144 + (p_ & 7) * 16) = st[3 + i_]; } \
            if (tid < 128) *(LAS float*)(q_ + HS_DEC + tid * 4) = stdec; } while (0)
#define HS_LOADI(dst_, c_) do { const size_t row0_ = (size_t)b * SEQ + (size_t)(c_) * 64; \
            _Pragma("unroll") for (int ks_ = 0; ks_ < 2; ++ks_) dst_[ks_] = *(const bf16x8*)(THI + (row0_ + (vcol >> 1)) * 512 + h * 128 + (vcol & 1) * 64 + 32 * ks_ + 8 * fq); } while (0)
        __syncthreads();
        HS_LOAD(0); HS_LOADI(bin, 0);
        HS_WRITE(0);
        __syncthreads();
        HS_LOAD(1);
#pragma unroll 1
        for (int c = 0; c < NCH; ++c) {
            bi[0] = bin[0]; bi[1] = bin[1];
            if (c + 1 < NCH) HS_LOADI(bin, c + 1);
            const LAS unsigned char* buf = lds + (c & 1) * HS_BUF;
            const size_t row0 = (size_t)b * SEQ + (size_t)c * 64;
#pragma unroll
            for (int rt = 0; rt < 4; ++rt) {
                f32x4 acc = (f32x4){0.f, 0.f, 0.f, 0.f};
#pragma unroll
                for (int ks = 0; ks < 2; ++ks) { const bf16x8 A = *(const LAS bf16x8*)(buf + HS_ATT + (16 * rt + fr) * 144 + (32 * ks + 8 * fq) * 2);
                    acc = __builtin_amdgcn_mfma_f32_16x16x32_bf16(A, bi[ks], acc, 0, 0, 0); }
#pragma unroll
                for (int ks = 0; ks < 4; ++ks) { const v2u lo = *(const LAS v2u*)(buf + HS_Q + (16 * rt + fr) * 272 + (32 * ks + 4 * fq) * 2), hi = *(const LAS v2u*)(buf + HS_Q + (16 * rt + fr) * 272 + (32 * ks + 16 + 4 * fq) * 2);
                    const v4u t4 = (v4u){lo.x, lo.y, hi.x, hi.y};
                    acc = __builtin_amdgcn_mfma_f32_16x16x32_bf16(__builtin_bit_cast(bf16x8, t4), Sb[ks], acc, 0, 0, 0); }
#pragma unroll
                for (int r = 0; r < 4; ++r) HO[(row0 + 16 * rt + 4 * fq + r) * 512 + h * 128 + vcol] = (bf16)f2bf(acc[r]);
            }
#pragma unroll
            for (int dt = 0; dt < 8; ++dt) {
                const f32x4 dec4 = *(const LAS f32x4*)(buf + HS_DEC + (16 * dt + 4 * fq) * 4);
                Sacc[dt] = Sacc[dt] * dec4;
#pragma unroll
                for (int ks = 0; ks < 2; ++ks) { const bf16x8 A = *(const LAS bf16x8*)(buf + HS_K + (16 * dt + fr) * 144 + (32 * ks + 8 * fq) * 2);
                    Sacc[dt] = __builtin_amdgcn_mfma_f32_16x16x32_bf16(A, bi[ks], Sacc[dt], 0, 0, 0); }
            }
#pragma unroll
            for (int ks = 0; ks < 4; ++ks) { const v4u t4 = (v4u){pk2(Sacc[2 * ks][0], Sacc[2 * ks][1]), pk2(Sacc[2 * ks][2], Sacc[2 * ks][3]), pk2(Sacc[2 * ks + 1][0], Sacc[2 * ks + 1][1]), pk2(Sacc[2 * ks + 1][2], Sacc[2 * ks + 1][3])};
                Sb[ks] = __builtin_bit_cast(bf16x8, t4); }
            if (c + 1 < NCH) { HS_WRITE((c + 1) & 1); if (c + 2 < NCH) HS_LOAD(c + 2); }
            __syncthreads();
        }
#undef HS_LOAD
#undef HS_WRITE
#undef HS_LOADI
        asm volatile("s_waitcnt vmcnt(0)" ::: "memory");
        __syncthreads();
        hgrn_post_bh(HO, (bf16*)(ws + A_THG), a->in[7] + l * 128, b, h, tid);
    }
}

typedef float f32x2q __attribute__((ext_vector_type(2)));
typedef __bf16 bf16x2n __attribute__((ext_vector_type(2)));
__device__ __forceinline__ v4u fp8x8_to_bf16(unsigned u0, unsigned u1) {
    return (v4u){__builtin_bit_cast(unsigned, __builtin_amdgcn_cvt_scalef32_pk_bf16_fp8(u0, 1.0f, false)), __builtin_bit_cast(unsigned, __builtin_amdgcn_cvt_scalef32_pk_bf16_fp8(u0, 1.0f, true)),
                 __builtin_bit_cast(unsigned, __builtin_amdgcn_cvt_scalef32_pk_bf16_fp8(u1, 1.0f, false)), __builtin_bit_cast(unsigned, __builtin_amdgcn_cvt_scalef32_pk_bf16_fp8(u1, 1.0f, true))};
}
__device__ __forceinline__ v2u tr_read(unsigned addr) { v2u r; asm volatile("ds_read_b64_tr_b16 %0, %1" : "=&v"(r) : "v"(addr) : "memory"); return r; }
__device__ __forceinline__ int vimg_off(int row, int ch) { return 256 * row + 16 * (ch ^ (((row & 3) << 2) | ((row >> 2) & 3))); }
constexpr int AT_WAVE = 16896, AT_IDX = 16384;
__device__ __forceinline__ void phase_attention(ArgsP a, LAS unsigned char* lds, int l, int G, int bid, int wv) {
    unsigned char* ws = a->ws;
    bf16* TQ = (bf16*)(ws + A_TQ); bf16* TOUT = TQ; const unsigned char* TKV8 = (const unsigned char*)(ws + A_TKV);     const unsigned short* SEL = (const unsigned short*)(ws + A_SEL);
    const int tid = opaque_tid(wv), lane = tid & 63, wave = __builtin_amdgcn_readfirstlane(tid >> 6), fr = lane & 15, fq = lane >> 4;
    LAS unsigned char* vimg = lds + wave * AT_WAVE;
    LAS unsigned short* idxs = (LAS unsigned short*)(vimg + AT_IDX);
    const unsigned vimg_a = (unsigned)(unsigned long)vimg;
    bf16x8 bb;
    {   float f[8];
#pragma unroll
        for (int jj = 0; jj < 8; ++jj) f[jj] = (fr < 8) ? a->in[1][(8 * fq + jj) * 8 + fr] : 0.f;
        const v4u w = pack8((f32x4){f[0], f[1], f[2], f[3]}, (f32x4){f[4], f[5], f[6], f[7]}); bb = __builtin_bit_cast(bf16x8, w); }
    __syncthreads();
    const int b = bid & 7;
    unsigned* ticket = (unsigned*)(ws + WS_CTL) + CW_TICKET + (l * 8 + b) * 64;
    int tnext = 0;
    constexpr int AT_BIG = (SEQ / 8 * 7) / 4;
#define AT_TICKET_Q(c_) ((c_) < AT_BIG ? 4 * (c_) : 4 * AT_BIG + ((c_) - AT_BIG))
    if (lane == 0) { const int c = (int)__hip_atomic_fetch_add(ticket, 1u, __ATOMIC_RELAXED, __HIP_MEMORY_SCOPE_AGENT); tnext = AT_TICKET_Q(c); }
    const unsigned char* kvb = TKV8 + (size_t)b * SEQ * 256;
    const int tq = fr >> 2, tp = fr & 3;
    v2u idxnext = (v2u){0u, 0u};
    v4u pend = (v4u){0u, 0u, 0u, 0u}; int prow = -1;
    {   const int t0 = __builtin_amdgcn_readfirstlane(tnext);
        if (t0 < SEQ) idxnext = *(const v2u*)((const unsigned char*)(SEL + ((size_t)b * SEQ + t0) * 256) + (unsigned)lane * 8u); }
#pragma unroll 1
    for (;;) {
        const int t = __builtin_amdgcn_readfirstlane(tnext);
        if (t >= SEQ) break;
        if ((t & 3) == 3 || t >= 4 * AT_BIG) { if (lane == 0) { const int c = (int)__hip_atomic_fetch_add(ticket, 1u, __ATOMIC_RELAXED, __HIP_MEMORY_SCOPE_AGENT); tnext = AT_TICKET_Q(c); } } else tnext = t + 1;
        const size_t row = (size_t)b * SEQ + t;
        const int n = t + 1 < 256 ? t + 1 : 256;
        *(LAS v2u*)(idxs + lane * 4) = idxnext;
        bf16x8 bq[4];
        {   v4u w0 = (v4u){0u, 0u, 0u, 0u}, w1 = w0;
            if (fr < 8) { float f[8], g8[8]; const bf16* qp = TQ + row * 512 + fr * 64 + 16 * fq;
                unpack8(*(const v4u*)qp, f); unpack8(*(const v4u*)(qp + 8), g8);
                w0 = pack8((f32x4){f[0] * 0.125f, f[1] * 0.125f, f[2] * 0.125f, f[3] * 0.125f}, (f32x4){f[4] * 0.125f, f[5] * 0.125f, f[6] * 0.125f, f[7] * 0.125f});
                w1 = pack8((f32x4){g8[0] * 0.125f, g8[1] * 0.125f, g8[2] * 0.125f, g8[3] * 0.125f}, (f32x4){g8[4] * 0.125f, g8[5] * 0.125f, g8[6] * 0.125f, g8[7] * 0.125f}); }
            const v4u z = (v4u){0u, 0u, 0u, 0u}; const bool g1 = (fr >> 2) == 1;
            bq[0] = __builtin_bit_cast(bf16x8, g1 ? z : w0); bq[1] = __builtin_bit_cast(bf16x8, g1 ? z : w1);
            bq[2] = __builtin_bit_cast(bf16x8, g1 ? w0 : z); bq[3] = __builtin_bit_cast(bf16x8, g1 ? w1 : z); }
        LDS_WAIT();
        f32x4 acc[16]; v4u KA[16][2]; int kix[16];
#define AT_KLOAD(tile_) do { const int slot_ = (tile_) * 16 + fr; kix[tile_] = (int)idxs[slot_]; const unsigned char* kp_ = kvb + (size_t)kix[tile_] * 256 + 16 * fq; \
            KA[tile_][0] = *(const v4u*)kp_; KA[tile_][1] = *(const v4u*)(kp_ + 64); } while (0)
        AT_KLOAD(0); AT_KLOAD(1); AT_KLOAD(2);
        asm volatile("" ::: "memory");
#pragma unroll
        for (int tile = 0; tile < 16; ++tile) {
            if (tile + 3 < 16) { AT_KLOAD(tile + 3); asm volatile("" ::: "memory"); }
            const int dist = t - kix[tile];
            int bu = dist;
            if (dist >= 16) { bu = 16 + (int)((__log2f((float)dist) - 4.0f) * (16.0f / 3.0f)); bu = bu > 31 ? 31 : bu; }
            const unsigned mhot = ((bu >> 3) == fq) ? (0x3F80u << ((bu & 1) * 16)) : 0u; const int wsel = (bu >> 1) & 3;
            const v4u oh = (v4u){wsel == 0 ? mhot : 0u, wsel == 1 ? mhot : 0u, wsel == 2 ? mhot : 0u, wsel == 3 ? mhot : 0u};
            f32x4 c;
#pragma unroll
            for (int g = 0; g < 2; ++g) { const v4u kw = KA[tile][g];
                c = __builtin_amdgcn_mfma_f32_16x16x32_bf16(__builtin_bit_cast(bf16x8, fp8x8_to_bf16(kw.x, kw.y)), bq[2 * g], g == 0 ? (f32x4){0.f, 0.f, 0.f, 0.f} : c, 0, 0, 0);
                c = __builtin_amdgcn_mfma_f32_16x16x32_bf16(__builtin_bit_cast(bf16x8, fp8x8_to_bf16(kw.z, kw.w)), bq[2 * g + 1], c, 0, 0, 0); }
            acc[tile] = __builtin_amdgcn_mfma_f32_16x16x32_bf16(__builtin_bit_cast(bf16x8, oh), bb, c, 0, 0, 0);
        }
#undef AT_KLOAD
        if (prow >= 0) *(v4u*)(TOUT + (size_t)prow * 512 + lane * 8) = pend;
        v4u VS[8][4];
#define AT_VLOAD(hc_) do { _Pragma("unroll") for (int i_ = 0; i_ < 4; ++i_) { const int p_ = lane + 64 * i_; const int slot_ = 32 * (hc_) + (p_ >> 3); const int kidx_ = (int)idxs[slot_]; \
            VS[hc_][i_] = *(const v4u*)(kvb + (size_t)kidx_ * 256 + 128 + 16 * (p_ & 7)); } } while (0)
        AT_VLOAD(0);
        {   const int tn = __builtin_amdgcn_readfirstlane(tnext); unsigned lo8 = (unsigned)lane * 8u; asm volatile("" : "+v"(lo8));
            if (tn < SEQ) idxnext = *(const v2u*)((const unsigned char*)(SEL + ((size_t)b * SEQ + tn) * 256) + lo8); }
        asm volatile("" ::: "memory");
        if (n < 256) {
#pragma unroll
            for (int tile = 0; tile < 16; ++tile)
#pragma unroll
                for (int r = 0; r < 4; ++r) if (tile * 16 + 4 * fq + r >= n) acc[tile][r] = -INFINITY;
        }
        float mx = -INFINITY;
#pragma unroll
        for (int tile = 0; tile < 16; ++tile) mx = fmaxf(mx, fmaxf(fmaxf(acc[tile][0], acc[tile][1]), fmaxf(acc[tile][2], acc[tile][3])));
        mx = fmaxf(mx, shx(mx, 16, lane)); mx = fmaxf(mx, shx(mx, 32, lane));
        float sum = 0.f;
#pragma unroll
        for (int tile = 0; tile < 16; ++tile)
#pragma unroll
            for (int r = 0; r < 4; ++r) { const float e = __expf(acc[tile][r] - mx); acc[tile][r] = e; sum += e; }
        sum += shx(sum, 16, lane); sum += shx(sum, 32, lane);
        const float inv = __builtin_amdgcn_rcpf(sum);
        bf16x8 Pa[8];
#pragma unroll
        for (int k2 = 0; k2 < 8; ++k2) { const v4u w = pack8(acc[2 * k2] * inv, acc[2 * k2 + 1] * inv); Pa[k2] = __builtin_bit_cast(bf16x8, w); }
        f32x4 o[2][4];
#pragma unroll
        for (int hc = 0; hc < 8; ++hc) {
            if (hc + 1 < 8) { AT_VLOAD(hc + 1); asm volatile("" ::: "memory"); }
            const int rb = 32 * (hc & 1);
#pragma unroll
            for (int i = 0; i < 4; ++i) { const int p = lane + 64 * i, rowl = rb + (p >> 3), c16 = p & 7;
                *(LAS v4u*)(vimg + vimg_off(rowl, 2 * c16)) = fp8x8_to_bf16(VS[hc][i].x, VS[hc][i].y);
                *(LAS v4u*)(vimg + vimg_off(rowl, 2 * c16 + 1)) = fp8x8_to_bf16(VS[hc][i].z, VS[hc][i].w); }
            LDS_WAIT();
#pragma unroll
            for (int g = 0; g < 2; ++g) {
                v2u lo[4], hi[4];
#pragma unroll
                for (int dt = 0; dt < 4; ++dt) { const int ch = 8 * g + 2 * dt + (tp >> 1), r0 = rb + 4 * fq + tq;
                    lo[dt] = tr_read(vimg_a + vimg_off(r0, ch) + 8 * (tp & 1)); hi[dt] = tr_read(vimg_a + vimg_off(r0 + 16, ch) + 8 * (tp & 1)); }
                asm volatile("s_waitcnt lgkmcnt(0)" : "+v"(lo[0]), "+v"(lo[1]), "+v"(lo[2]), "+v"(lo[3]), "+v"(hi[0]), "+v"(hi[1]), "+v"(hi[2]), "+v"(hi[3]) :: "memory");
#pragma unroll
                for (int dt = 0; dt < 4; ++dt) { const v4u w = (v4u){lo[dt].x, lo[dt].y, hi[dt].x, hi[dt].y};
                    o[g][dt] = __builtin_amdgcn_mfma_f32_16x16x32_bf16(Pa[hc], __builtin_bit_cast(bf16x8, w), hc == 0 ? (f32x4){0.f, 0.f, 0.f, 0.f} : o[g][dt], 0, 0, 0); }
            }
        }
#undef AT_VLOAD
        if (fq < 2) {
#pragma unroll
            for (int g = 0; g < 2; ++g) if (g == fq) {
#pragma unroll
                for (int dt = 0; dt < 4; ++dt)
#pragma unroll
                    for (int r = 0; r < 4; ++r) *(LAS unsigned short*)(vimg + ((4 * g + r) * 64 + dt * 16 + fr) * 2) = (unsigned short)f2bf(o[g][dt][r]); }
        }
        LDS_WAIT();
        pend = *(const LAS v4u*)(vimg + lane * 16); prow = (int)row;
        LDS_WAIT();
    }
    if (prow >= 0) *(v4u*)(TOUT + (size_t)prow * 512 + lane * 8) = pend;
}
#ifndef ONE_LAUNCH
#define ONE_LAUNCH 1
#endif
constexpr int NPH_LAYER = 8, NPHASE = 1 + NLAYER * NPH_LAYER;

__global__ void __launch_bounds__(NTHREADS, 2) fwd_kernel(Args args_unused) {
    extern __shared__ __attribute__((aligned(16))) unsigned char lds_raw[];
    LAS unsigned char* lds = (LAS unsigned char*)lds_raw;
    volatile LAS unsigned* misc = (volatile LAS unsigned*)(lds + MISC_OFF);
    if (threadIdx.x < 64) misc[threadIdx.x] = 0u;
    const int wv = __builtin_amdgcn_readfirstlane((int)threadIdx.x >> 6);
    __syncthreads();
    if (get_args()->ph_hi - get_args()->ph_lo > 1) (void)xcd_barrier_post((unsigned*)(get_args()->ws + WS_CTL) + CW_BAR, misc + 8);
#define PH_LO (get_args()->ph_lo)
#define PH_HI (get_args()->ph_hi)
#define IN(k) (PH_LO <= (k) && (k) < PH_HI)
#define SEAM(k) do { if ((k) + 1 < PH_HI) { XcdBarrier b_; b_.bar = (unsigned*)(get_args()->ws + WS_CTL) + CW_BAR; b_.x = xb_xcc_id(); b_.st = misc + 8; xcd_barrier(b_, opaque_tid(wv)); } } while (0)
#define GRID ((int)gridDim.x)
#define BID ((int)blockIdx.x)

    if (IN(0)) { phase_prologue(get_args(), lds, GRID, BID, wv); SEAM(0); }

#pragma unroll 1
    for (int l = 0; l < NLAYER; ++l) {
        const int p0 = 1 + l * NPH_LAYER;
#define WSP (get_args()->ws)
        if (IN(p0 + 0)) {
            ArgsP a = get_args(); unsigned char* ws = a->ws;
            pg8::Gemm g{(const bf16*)(ws + WS_XB), (const bf16*)(ws + WS_W + (size_t)l * W_LAYER + W_IN), MTOK, NINP, 1024}; pg8::StaticOrder S; S.init(MTOK, NINP, GRID, BID);
            pg8::EpiInProj E{(const u64*)(ws + WS_SSQ) + (size_t)(2 * l) * MTOK, (bf16*)(ws + A_TQ), (bf16*)(ws + A_TKV), (bf16*)(ws + A_TIQ), (bf16*)(ws + A_TIK), (float*)(ws + A_TIW),
                             (bf16*)(ws + A_THQ), (bf16*)(ws + A_THF), (bf16*)(ws + A_THI), (bf16*)(ws + A_THG), (bf16*)(ws + A_TCB), (bf16*)(ws + A_TU),
                             a->in[5] + l * 64, a->in[6] + l * 64, (const float*)(ws + WS_LB) + l * 512};
            pg8::gemm_phase<pg8::EpiInProj, pg8::StaticOrder, true, true>(lds, g, S, E, opaque_tid(wv));
            SEAM(p0 + 0);
        }
        if (IN(p0 + 1)) {
            phase_indexer(get_args(), lds, l, GRID, BID, wv);
            phase_hgrn_pre(get_args(), lds, GRID, BID, wv);
            phase_conv(get_args(), l, GRID, BID, wv);
            SEAM(p0 + 1);
        }
        if (IN(p0 + 2)) {
            phase_hgrn_seq(get_args(), lds, l, GRID, BID, wv);
            __syncthreads();
            phase_attention(get_args(), lds, l, GRID, BID, wv);
            SEAM(p0 + 2);
        }
        if (IN(p0 + 4)) {
            {   unsigned char* ws = WSP; pg8::StaticOrder S; S.init(MTOK, 1024, GRID, BID); pg8::EpiStoreBf16 EY{(bf16*)(ws + A_YB), 1024};
                pg8::Gemm g{(const bf16*)(ws + A_TQ), (const bf16*)(ws + WS_W + (size_t)l * W_LAYER + W_UA), MTOK, 1024, 512}; pg8::gemm_phase<pg8::EpiStoreBf16, pg8::StaticOrder, true, true>(lds, g, S, EY, opaque_tid(wv)); }
            {   unsigned char* ws = WSP; pg8::StaticOrder S; S.init(MTOK, 1024, GRID, BID); pg8::EpiGate<true> E{(const u64*)(ws + WS_SSQ) + (size_t)(2 * l) * MTOK, (const bf16*)(ws + A_YB), (bf16*)(ws + A_MIXED)};
                pg8::Gemm g{(const bf16*)(ws + WS_XB), (const bf16*)(ws + WS_W + (size_t)l * W_LAYER + W_G), MTOK, 1024, 1024}; pg8::gemm_phase<pg8::EpiGate<true>, pg8::StaticOrder, true, true>(lds, g, S, E, opaque_tid(wv)); }
            {   unsigned char* ws = WSP; pg8::StaticOrder S; S.init(MTOK, 1024, GRID, BID); pg8::EpiStoreBf16 EY{(bf16*)(ws + A_YB), 1024};
                pg8::Gemm g{(const bf16*)(ws + A_THG), (const bf16*)(ws + WS_W + (size_t)l * W_LAYER + W_UH), MTOK, 1024, 512}; pg8::gemm_phase<pg8::EpiStoreBf16, pg8::StaticOrder, true, true>(lds, g, S, EY, opaque_tid(wv)); }
            {   unsigned char* ws = WSP; pg8::StaticOrder S; S.init(MTOK, 1024, GRID, BID); pg8::EpiGate<false> E{(const u64*)(ws + WS_SSQ) + (size_t)(2 * l) * MTOK, (const bf16*)(ws + A_YB), (bf16*)(ws + A_MIXED)};
                pg8::Gemm g{(const bf16*)(ws + WS_XB), (const bf16*)(ws + WS_W + (size_t)l * W_LAYER + W_G + 2 * MiB), MTOK, 1024, 1024}; pg8::gemm_phase<pg8::EpiGate<false>, pg8::StaticOrder, true, true>(lds, g, S, E, opaque_tid(wv)); }
            {   unsigned char* ws = WSP; pg8::StaticOrder S; S.init(MTOK, 1024, GRID, BID); pg8::EpiStoreBf16 EY{(bf16*)(ws + A_YB), 1024};
                pg8::Gemm g{(const bf16*)(ws + A_TCB), (const bf16*)(ws + WS_W + (size_t)l * W_LAYER + W_UC), MTOK, 1024, 512}; pg8::gemm_phase<pg8::EpiStoreBf16, pg8::StaticOrder, true, true>(lds, g, S, EY, opaque_tid(wv)); }
            {   unsigned char* ws = WSP; pg8::StaticOrder S; S.init(MTOK, 1024, GRID, BID); pg8::EpiGate<false> E{(const u64*)(ws + WS_SSQ) + (size_t)(2 * l) * MTOK, (const bf16*)(ws + A_YB), (bf16*)(ws + A_MIXED)};
                pg8::Gemm g{(const bf16*)(ws + WS_XB), (const bf16*)(ws + WS_W + (size_t)l * W_LAYER + W_G + 4 * MiB), MTOK, 1024, 1024}; pg8::gemm_phase<pg8::EpiGate<false>, pg8::StaticOrder, true, true>(lds, g, S, E, opaque_tid(wv)); }
            SEAM(p0 + 4);
        }
        if (IN(p0 + 5)) {
            ArgsP a = get_args(); unsigned char* ws = a->ws;
            pg8::Gemm g{(const bf16*)(ws + A_MIXED), (const bf16*)(ws + WS_W + (size_t)l * W_LAYER + W_O), MTOK, 1024, 1024}; pg8::StaticOrder S; S.init(MTOK, 1024, GRID, BID);
            pg8::EpiResidual E{(bf16*)(ws + WS_XB), (float*)nullptr, (u64*)(ws + WS_SSQ) + (size_t)(2 * l + 1) * MTOK, (const u64*)nullptr};
            pg8::gemm_phase<pg8::EpiResidual, pg8::StaticOrder, true, true>(lds, g, S, E, opaque_tid(wv));
            SEAM(p0 + 5);
        }
        if (IN(p0 + 6)) {
            unsigned char* ws = WSP;
            pg8::Gemm g{(const bf16*)(ws + WS_XB), (const bf16*)(ws + WS_W + (size_t)l * W_LAYER + W_UP), MTOK, DFF, 1024}; pg8::StaticOrder S; S.init(MTOK, DFF, GRID, BID);
            pg8::EpiMlpUp E{(bf16*)(ws + A_HIDDEN)};
            pg8::gemm_phase<pg8::EpiMlpUp, pg8::StaticOrder, true, true>(lds, g, S, E, opaque_tid(wv));
            SEAM(p0 + 6);
        }
        if (IN(p0 + 7)) {
            ArgsP a = get_args(); unsigned char* ws = a->ws;
            pg8::Gemm g{(const bf16*)(ws + A_HIDDEN), (const bf16*)(ws + WS_W + (size_t)l * W_LAYER + W_DN), MTOK, 1024, DFF}; pg8::StaticOrder S; S.init(MTOK, 1024, GRID, BID);
            pg8::EpiResidual E{(bf16*)(ws + WS_XB), (l + 1 < NLAYER) ? (float*)nullptr : a->out, (l + 1 < NLAYER) ? (u64*)(ws + WS_SSQ) + (size_t)(2 * l + 2) * MTOK : (u64*)nullptr, (const u64*)(ws + WS_SSQ) + (size_t)(2 * l + 1) * MTOK};
            pg8::gemm_phase<pg8::EpiResidual, pg8::StaticOrder, true, true>(lds, g, S, E, opaque_tid(wv));
            SEAM(p0 + 7);
        }
    }
#undef IN
#undef SEAM
}

extern "C" void kernel_launch(void* const* d_in, const int* in_sizes, int n_in, void* d_out, int out_size, void* d_ws, size_t ws_size, hipStream_t stream) {
    static int grid = 0;
    if (grid == 0) {
        if (n_in != 16 || in_sizes[0] != MTOK * DM || out_size != MTOK * DM || ws_size < WS_END) {
            fprintf(stderr, "kernel_launch: unexpected shapes / workspace (n_in %d, in0 %d, out %d, ws %zu, need %zu); nothing launched\n", n_in, n_in > 0 ? in_sizes[0] : -1, out_size, ws_size, (size_t)WS_END);
            grid = -1; return; }
        int dev = 0, cus = 0, per_cu = 0;
        if (hipGetDevice(&dev) != hipSuccess || hipDeviceGetAttribute(&cus, hipDeviceAttributeMultiprocessorCount, dev) != hipSuccess) { grid = -1; return; }
        if (hipFuncSetAttribute((const void*)fwd_kernel, hipFuncAttributeMaxDynamicSharedMemorySize, LDS_BYTES) != hipSuccess) { fprintf(stderr, "kernel_launch: hipFuncSetAttribute failed\n"); grid = -1; return; }
        if (hipOccupancyMaxActiveBlocksPerMultiprocessor(&per_cu, (const void*)fwd_kernel, NTHREADS, LDS_BYTES) != hipSuccess || per_cu < 1) fprintf(stderr, "kernel_launch: occupancy query reports %d\n", per_cu);
        (void)hipGetLastError();
        grid = cus;
    }
    if (grid < 0) return;
    if (hipMemsetAsync((char*)d_ws + WS_CTL, 0, CTL_ZERO_BYTES, stream) != hipSuccess) { fprintf(stderr, "kernel_launch: memset failed\n"); return; }
    Args a{};
    for (int i = 0; i < 16; ++i) a.in[i] = (const float*)d_in[i];
    a.out = (float*)d_out; a.ws = (unsigned char*)d_ws;
#if ONE_LAUNCH
    a.ph_lo = 0; a.ph_hi = NPHASE;
    hipLaunchKernelGGL(fwd_kernel, dim3(grid), dim3(NTHREADS), LDS_BYTES, stream, a);
#else
    for (int p = 0; p < NPHASE; ++p) { a.ph_lo = p; a.ph_hi = p + 1; hipLaunchKernelGGL(fwd_kernel, dim3(grid), dim3(NTHREADS), LDS_BYTES, stream, a); }
#endif
    const hipError_t le = hipPeekAtLastError();
    if (le != hipSuccess) fprintf(stderr, "kernel_launch: launch failed: %s\n", hipGetErrorName(le));
}
```

```cpp
#include <hip/hip_runtime.h>
#include <cstdio>
#include <cstdint>
#define ONE_LAUNCH 1
namespace pg8 {
#define PG8_LAS __attribute__((address_space(3)))
typedef unsigned short bf16_t;
typedef short bf16x8 __attribute__((ext_vector_type(8)));
typedef float f32x4 __attribute__((ext_vector_type(4)));
typedef unsigned u32x4 __attribute__((ext_vector_type(4)));
constexpr int BM = 256, BK = 64, HALF = 128, HTB = HALF * BK * 2  , STAGE_BYTES = 8 * HTB, NXCD = 8, WGM = 8;

__host__ __device__ __forceinline__ int lds_byte(int r, int c) { const int st = (r >> 4) * 2 + (c >> 5), rr = r & 15, cc = c & 31, ob = rr * 64 + cc * 2; return st * 1024 + (ob ^ (((ob >> 9) & 1) << 5)); }
__host__ __device__ __forceinline__ void stage_rc(int b, int& R, int& C) { const int st = b / 1024, sb = b % 1024, swz = sb ^ (((sb >> 9) & 1) << 5); R = (st >> 1) * 16 + swz / 64; C = (st & 1) * 32 + (swz % 64) / 2; }
__host__ __device__ __forceinline__ int perm32(int rho) { const int n = rho >> 4, i = rho & 15; return 8 * (i >> 2) + 4 * n + (i & 3); }

struct Unit { int pm, pn; };
struct Gemm { const bf16_t* A; const bf16_t* Bt; int M, N, K; };

struct StaticOrder {
    int nM, nN, nwg, G, c;
    __host__ __device__ void init(int M, int N, int G_, int c_) { nM = M / BM; nN = N / BM; nwg = nM * nN; G = G_; c = c_; }
    __host__ __device__ bool next(int i, Unit& u) const {
        const long L = (long)i * G + c; if (L >= nwg) return false;
        int wgid = (int)L; { const int q = nwg / NXCD, r = nwg % NXCD, xcd = wgid % NXCD, off = wgid / NXCD; wgid = (xcd < r ? xcd * (q + 1) : r * (q + 1) + (xcd - r) * q) + off; }
        const int nig = WGM * nN, gid = wgid / nig, fm = gid * WGM, gsz = (nM - fm) < WGM ? (nM - fm) : WGM;
        u.pm = fm + ((wgid % nig) % gsz); u.pn = (wgid % nig) / gsz; return true;
    }
    __device__ __forceinline__ void a_ready(const Unit&) const {}
    __device__ __forceinline__ void done(const Unit&) const {}
};
__device__ __forceinline__ unsigned cvt_pk_bf16(float lo, float hi) { unsigned r; asm volatile("v_cvt_pk_bf16_f32 %0, %1, %2" : "=v"(r) : "v"(lo), "v"(hi)); return r; }
typedef float f32x2 __attribute__((ext_vector_type(2)));
template <class Epi, class Sched, bool ALIGN_EPI = false, bool SP2 = false>
__device__ __forceinline__ void gemm_phase(PG8_LAS unsigned char* lds, const Gemm g, const Sched& S, const Epi& E, int tid_in) {
    int tid_l = tid_in; asm volatile("" : "+v"(tid_l));
    const int tid = tid_l, wid = __builtin_amdgcn_readfirstlane(tid >> 6), lane = tid & 63, wr = wid >> 2, wc = wid & 3, fr = lane & 15, fq = lane >> 4;
    const int K = g.K, nt = K / BK;
    unsigned voffA[2], voffB[2];
#pragma unroll
    for (int i = 0; i < 2; ++i) { int R, C; stage_rc(tid * 16 + i * 8192, R, C); const int Rb = Epi::PERM ? ((R & ~31) + perm32(R & 31)) : R;
        voffA[i] = (unsigned)(R * K + C) * 2u; voffB[i] = (unsigned)(Rb * K + C) * 2u; }
    const size_t kstep = (size_t)(BK * 2);
    const size_t hstep = (size_t)HALF * K * 2;
    const size_t tstep = 2 * hstep;
    const unsigned ldsw = (unsigned)wid * 1024u;
    const int aoff = lds_byte(wr * 64 + fr, fq * 8), boff = lds_byte(wc * 32 + fr, fq * 8);
#define PG8_SA(b, h) (((b) * 2 + (h)) * HTB)
#define PG8_SB(b, h) ((4 + (b) * 2 + (h)) * HTB)
#define PG8_STAGE(bufoff, gbase, voff) do { _Pragma("unroll") for (int _i = 0; _i < 2; ++_i) \
        __builtin_amdgcn_global_load_lds((const unsigned*)((const char*)(gbase) + (voff)[_i]), (PG8_LAS unsigned*)(lds + (bufoff) + ldsw + _i * 8192), 16, 0, 0); } while (0)
#define PG8_LDA(dst, b, h) do { _Pragma("unroll") for (int m = 0; m < 4; ++m) _Pragma("unroll") for (int k = 0; k < 2; ++k) dst[m][k] = *(const PG8_LAS bf16x8*)(lds + PG8_SA(b, h) + aoff + m * 2048 + k * 1024); } while (0)
#define PG8_LDB(dst, b, h) do { _Pragma("unroll") for (int n = 0; n < 2; ++n) _Pragma("unroll") for (int k = 0; k < 2; ++k) dst[n][k] = *(const PG8_LAS bf16x8*)(lds + PG8_SB(b, h) + boff + n * 2048 + k * 1024); } while (0)
#define PG8_MMA(ai, bj, At, Bt) do { __builtin_amdgcn_s_setprio(1); _Pragma("unroll") for (int m = 0; m < 4; ++m) _Pragma("unroll") for (int n = 0; n < 2; ++n) _Pragma("unroll") for (int k = 0; k < 2; ++k) \
        acc[ai][bj][m][n] = __builtin_amdgcn_mfma_f32_16x16x32_bf16(Bt[n][k], At[m][k], acc[ai][bj][m][n], 0, 0, 0); __builtin_amdgcn_s_setprio(0); } while (0)
#define PG8_WAIT_V(n) asm volatile("s_waitcnt vmcnt(" #n ")" ::: "memory")
#define PG8_WAIT_L(n) asm volatile("s_waitcnt lgkmcnt(" #n ")" ::: "memory")
#define PG8_BAR __builtin_amdgcn_s_barrier()
#define PG8_SCHED __builtin_amdgcn_sched_barrier(0)
    Unit cur, nxt; int ui = 0;
    if (!S.next(0, cur)) return;
    f32x4 acc[2][2][4][2];
#pragma unroll
    for (int a = 0; a < 2; ++a)
#pragma unroll
        for (int b = 0; b < 2; ++b)
#pragma unroll
            for (int m = 0; m < 4; ++m)
#pragma unroll
                for (int n = 0; n < 2; ++n) acc[a][b][m][n] = (f32x4){0.f, 0.f, 0.f, 0.f};
    bf16x8 At[4][2], B0[2][2], B1[2][2];
    const char* cA = (const char*)g.A + (size_t)cur.pm * tstep; const char* cB = (const char*)g.Bt + (size_t)cur.pn * tstep;
    S.a_ready(cur);
    if constexpr (SP2) {
        PG8_STAGE(PG8_SB(0, 0), cB, voffB); PG8_STAGE(PG8_SB(0, 1), cB + hstep, voffB); PG8_STAGE(PG8_SA(0, 0), cA, voffA); PG8_STAGE(PG8_SA(0, 1), cA + hstep, voffA);
        if (wr == 1) PG8_BAR;
        PG8_WAIT_V(2); PG8_BAR;
        PG8_STAGE(PG8_SB(1, 0), cB + kstep, voffB); PG8_STAGE(PG8_SA(1, 0), cA + kstep, voffA); PG8_STAGE(PG8_SB(1, 1), cB + hstep + kstep, voffB);
        PG8_WAIT_V(6); PG8_BAR;
    } else {
        PG8_STAGE(PG8_SB(0, 0), cB, voffB); PG8_STAGE(PG8_SA(0, 0), cA, voffA); PG8_STAGE(PG8_SB(0, 1), cB + hstep, voffB); PG8_STAGE(PG8_SA(0, 1), cA + hstep, voffA);
        if (wr == 1) PG8_BAR;
        PG8_WAIT_V(4); PG8_BAR;
        PG8_STAGE(PG8_SB(1, 0), cB + kstep, voffB); PG8_STAGE(PG8_SA(1, 0), cA + kstep, voffA); PG8_STAGE(PG8_SB(1, 1), cB + hstep + kstep, voffB);
        PG8_WAIT_V(6); PG8_BAR;
    }
    for (;;) {
        const bool has_next = S.next(ui + 1, nxt);
        const char* nA = has_next ? (const char*)g.A + (size_t)nxt.pm * tstep : cA; const char* nB = has_next ? (const char*)g.Bt + (size_t)nxt.pn * tstep : cB;
        for (int t = 0; t < nt; t += 2) {
            const bool last = (t == nt - 2);
            const char* a1 = cA + (size_t)(t + 1) * kstep;
            const char* a2 = last ? nA : cA + (size_t)(t + 2) * kstep; const char* b2 = last ? nB : cB + (size_t)(t + 2) * kstep;
            const char* a3 = a2 + kstep; const char* b3 = b2 + kstep;
            if (last && has_next) S.a_ready(nxt);
            if constexpr (SP2) {
            PG8_LDB(B0, 0, 0); PG8_LDB(B1, 0, 1); PG8_SCHED; PG8_LDA(At, 0, 0); PG8_STAGE(PG8_SA(1, 1), a1 + hstep, voffA);
            PG8_WAIT_V(8); PG8_WAIT_L(0); PG8_BAR; PG8_MMA(0, 0, At, B0); PG8_MMA(0, 1, At, B1); PG8_BAR; PG8_SCHED;
            PG8_LDA(At, 0, 1); PG8_STAGE(PG8_SB(0, 0), b2, voffB); PG8_STAGE(PG8_SB(0, 1), b2 + hstep, voffB); PG8_STAGE(PG8_SA(0, 0), a2, voffA);
            PG8_WAIT_V(8); PG8_WAIT_L(0); PG8_BAR; PG8_MMA(1, 0, At, B0); PG8_MMA(1, 1, At, B1); PG8_BAR; PG8_SCHED;
            PG8_LDB(B0, 1, 0); PG8_LDB(B1, 1, 1); PG8_SCHED; PG8_LDA(At, 1, 0); PG8_STAGE(PG8_SA(0, 1), a2 + hstep, voffA);
            PG8_WAIT_V(8); PG8_WAIT_L(0); PG8_BAR; PG8_MMA(0, 0, At, B0); PG8_MMA(0, 1, At, B1); PG8_BAR; PG8_SCHED;
            PG8_LDA(At, 1, 1); PG8_STAGE(PG8_SB(1, 0), b3, voffB); PG8_STAGE(PG8_SB(1, 1), b3 + hstep, voffB); PG8_STAGE(PG8_SA(1, 0), a3, voffA);
            PG8_WAIT_V(8); PG8_WAIT_L(0); PG8_BAR; PG8_MMA(1, 0, At, B0); PG8_MMA(1, 1, At, B1); PG8_BAR; PG8_SCHED;
            } else {
            PG8_LDB(B0, 0, 0); PG8_SCHED; PG8_LDA(At, 0, 0); PG8_STAGE(PG8_SA(1, 1), a1 + hstep, voffA);
            PG8_WAIT_L(8); PG8_BAR; PG8_WAIT_L(0); PG8_MMA(0, 0, At, B0); PG8_BAR; PG8_SCHED;
            PG8_LDB(B1, 0, 1); PG8_STAGE(PG8_SB(0, 0), b2, voffB);
            PG8_BAR; PG8_WAIT_L(0); PG8_MMA(0, 1, At, B1); PG8_BAR;
            PG8_LDA(At, 0, 1); PG8_STAGE(PG8_SA(0, 0), a2, voffA);
            PG8_BAR; PG8_WAIT_L(0); PG8_MMA(1, 0, At, B0); PG8_BAR; PG8_SCHED;
            PG8_STAGE(PG8_SB(0, 1), b2 + hstep, voffB);
            PG8_WAIT_V(6); PG8_BAR; PG8_MMA(1, 1, At, B1); PG8_BAR;
            PG8_LDB(B0, 1, 0); PG8_SCHED; PG8_LDA(At, 1, 0); PG8_STAGE(PG8_SA(0, 1), a2 + hstep, voffA);
            PG8_WAIT_L(8); PG8_BAR; PG8_WAIT_L(0); PG8_MMA(0, 0, At, B0); PG8_BAR; PG8_SCHED;
            PG8_LDB(B1, 1, 1); PG8_STAGE(PG8_SB(1, 0), b3, voffB);
            PG8_BAR; PG8_WAIT_L(0); PG8_MMA(0, 1, At, B1); PG8_BAR;
            PG8_LDA(At, 1, 1); PG8_STAGE(PG8_SA(1, 0), a3, voffA);
            PG8_BAR; PG8_WAIT_L(0); PG8_MMA(1, 0, At, B0); PG8_BAR; PG8_SCHED;
            PG8_STAGE(PG8_SB(1, 1), b3 + hstep, voffB);
            PG8_WAIT_V(6); PG8_BAR; PG8_MMA(1, 1, At, B1); PG8_BAR;
            }
        }
        if constexpr (ALIGN_EPI) { if (wr == 0) PG8_BAR; }
        if constexpr (!Epi::AFTER_DRAIN) { E(acc, cur, wr, wc, fr, fq); S.done(cur); }
        if (!has_next) break;
#pragma unroll
        for (int a = 0; a < 2; ++a)
#pragma unroll
            for (int b = 0; b < 2; ++b)
#pragma unroll
                for (int m = 0; m < 4; ++m)
#pragma unroll
                    for (int n = 0; n < 2; ++n) acc[a][b][m][n] = (f32x4){0.f, 0.f, 0.f, 0.f};
        cur = nxt; cA = nA; cB = nB; ++ui;
        if constexpr (ALIGN_EPI) { if (wr == 1) PG8_BAR; }
    }
    PG8_WAIT_V(0);
    if constexpr (!ALIGN_EPI) { if (wr == 0) PG8_BAR; }
    PG8_BAR;
    if constexpr (Epi::AFTER_DRAIN) { E.fused(acc, cur, wr, wc, fr, fq, lds, wid, lane); S.done(cur); }
#undef PG8_SA
#undef PG8_SB
#undef PG8_STAGE
#undef PG8_LDA
#undef PG8_LDB
#undef PG8_MMA
#undef PG8_WAIT_V
#undef PG8_WAIT_L
#undef PG8_BAR
#undef PG8_SCHED
}
}

#define LAS __attribute__((address_space(3)))
typedef unsigned short bf16;
typedef unsigned v4u __attribute__((ext_vector_type(4)));
typedef unsigned v2u __attribute__((ext_vector_type(2)));
typedef float f32x4 __attribute__((ext_vector_type(4)));
typedef float f32x16 __attribute__((ext_vector_type(16)));
typedef short bf16x8 __attribute__((ext_vector_type(8)));

constexpr int NTHREADS = 512, NWAVES = 8;
constexpr int MTOK = 65536, DM = 1024, SEQ = 8192, NBATCH = 8, DFF = 4096, NLAYER = 2;
constexpr int DIN = 7748, NINP = 4864;
constexpr float EPS = 1e-6f;

constexpr size_t MiB = 1u << 20;
constexpr size_t WS_CTL = 0, CTL_ZERO_BYTES = 1 * MiB;
constexpr size_t WS_LB = 1 * MiB;
constexpr size_t WS_SSQ = 1 * MiB + 65536;
constexpr size_t WS_W = 4 * MiB, W_LAYER = 37 * MiB;
constexpr size_t W_IN = 0, W_G = 9 * MiB + 512 * 1024, W_UA = W_G + 6 * MiB, W_UH = W_UA + MiB, W_UC = W_UH + MiB, W_O = W_UC + MiB, W_UP = W_O + 2 * MiB, W_DN = W_UP + 8 * MiB;
static_assert(W_DN + 8 * MiB <= W_LAYER, "weights map");
constexpr size_t WS_XB = 80 * MiB;
constexpr size_t ARENA = 208 * MiB;
constexpr size_t A_THQ = ARENA, A_THF = ARENA + 64 * MiB, A_THI = ARENA + 128 * MiB, A_TU = ARENA + 192 * MiB, A_TQ = ARENA + 256 * MiB,
                 A_TKV = ARENA + 320 * MiB, A_TIQ = ARENA + 352 * MiB, A_TIK = ARENA + 384 * MiB, A_TIW = ARENA + 392 * MiB, A_THG = ARENA + 393 * MiB,
                 A_TCB = ARENA + 457 * MiB, A_SEL = ARENA + 521 * MiB, A_HATTN = ARENA + 553 * MiB, A_HDEC = ARENA + 585 * MiB, A_HO = ARENA + 587 * MiB,
                 A_SCR = ARENA + 651 * MiB,
                 WS_END = ARENA + 651 * MiB + 128 * MiB;
constexpr size_t A_YB = ARENA, A_MIXED = ARENA + 128 * MiB, A_HIDDEN = ARENA;
constexpr int CW_TICKET = 16384;
constexpr int CW_BAR = 4096;

constexpr int LDS_MAIN = 131072, LDS_AUX = 131072, LDS_AUX_BYTES = 16384, MISC_OFF = LDS_AUX + LDS_AUX_BYTES, LDS_BYTES = MISC_OFF + 256;

__device__ __forceinline__ float bf2f(unsigned b) { return __uint_as_float(b << 16); }
__device__ __forceinline__ float bflo(unsigned u) { return __uint_as_float(u << 16); }
__device__ __forceinline__ float bfhi(unsigned u) { return __uint_as_float(u & 0xffff0000u); }
__device__ __forceinline__ unsigned f2bf(float f) { unsigned u = __float_as_uint(f); return (u + 0x7fffu + ((u >> 16) & 1u)) >> 16; }
typedef float f32x2c __attribute__((ext_vector_type(2)));
typedef __bf16 bf16x2c __attribute__((ext_vector_type(2)));
__device__ __forceinline__ unsigned pk2(float lo, float hi) { const f32x2c v = {lo, hi}; const bf16x2c r = __builtin_convertvector(v, bf16x2c); return __builtin_bit_cast(unsigned, r); }
__device__ __forceinline__ v4u pack8(const f32x4 a, const f32x4 b) { v4u w; w.x = pk2(a[0], a[1]); w.y = pk2(a[2], a[3]); w.z = pk2(b[0], b[1]); w.w = pk2(b[2], b[3]); return w; }
__device__ __forceinline__ void unpack8(const v4u w, float (&f)[8]) { f[0] = bflo(w.x); f[1] = bfhi(w.x); f[2] = bflo(w.y); f[3] = bfhi(w.y); f[4] = bflo(w.z); f[5] = bfhi(w.z); f[6] = bflo(w.w); f[7] = bfhi(w.w); }
#define LDS_WAIT() asm volatile("s_waitcnt lgkmcnt(0)" ::: "memory")
__device__ __forceinline__ float shx(float v, int m, int lane) { return __int_as_float(__builtin_amdgcn_ds_bpermute((lane ^ m) << 2, __float_as_int(v))); }
__device__ __forceinline__ float wave_sum(float v, int lane) {
#pragma unroll
    for (int o = 1; o < 64; o <<= 1) v += shx(v, o, lane);
    return v;
}
__device__ __forceinline__ float wave_max(float v, int lane) {
#pragma unroll
    for (int o = 1; o < 64; o <<= 1) v = fmaxf(v, shx(v, o, lane));
    return v;
}
__device__ __forceinline__ float sigmoidf_(float z) { return __builtin_amdgcn_rcpf(1.0f + __expf(-z)); }

struct Args { const float* in[16]; float* out; unsigned char* ws; int ph_lo, ph_hi; };
typedef const __attribute__((address_space(4))) Args* ArgsP;
typedef unsigned long long u64;
__device__ __forceinline__ unsigned ssq_fix(float s) { return (unsigned)(s * 65536.0f + 0.5f); }
__device__ __forceinline__ float ssq_val(u64 v) { return ((float)(unsigned)(v >> 32) * 4294967296.0f + (float)(unsigned)v) * (1.0f / 65536.0f); }
__device__ __forceinline__ ArgsP get_args() { const __attribute__((address_space(4))) void* p = (const __attribute__((address_space(4))) void*)__builtin_amdgcn_kernarg_segment_ptr(); asm volatile("" : "+s"(p)); return (ArgsP)p; }

namespace pg8 {

struct EpiInProj {
    static constexpr bool PERM = true, AFTER_DRAIN = false;
    const u64* ssq; bf16 *TQ, *TKV, *TIQ, *TIK; float* TIW; bf16 *THQ, *THF, *THI, *THG, *TCB, *TU;
    const float *qg, *kg, *lb;
    __device__ __forceinline__ void operator()(const f32x4 (&acc)[2][2][4][2], const Unit& u, int wr, int wc, int fr_in, int fq_in) const {
        int fr = fr_in, fq = fq_in; asm volatile("" : "+v"(fr), "+v"(fq)); const int lane_ = fq * 16 + fr; (void)lane_;
        const int t = u.pn;
        const int lc0 = 64 * wc + 8 * fq;
        u64 rs[2][4];
#pragma unroll
        for (int ai = 0; ai < 2; ++ai)
#pragma unroll
            for (int m = 0; m < 4; ++m) rs[ai][m] = ssq[(size_t)u.pm * 256 + ai * 128 + wr * 64 + m * 16 + fr];
        f32x4 cc[2][2];
        {   const float* cp = (t < 2) ? qg + 8 * fq : (t == 2) ? kg + 8 * fq : lb + 256 * ((t - 5) & 1) + lc0;
            const bool use = (t <= 2) || (t == 7) || (t == 8);
#pragma unroll
            for (int bj = 0; bj < 2; ++bj)
#pragma unroll
                for (int n = 0; n < 2; ++n) cc[bj][n] = use ? *(const f32x4*)(cp + 32 * bj + 4 * n) : (f32x4){0.f, 0.f, 0.f, 0.f}; }
#pragma unroll
        for (int ai = 0; ai < 2; ++ai)
#pragma unroll
            for (int m = 0; m < 4; ++m) {
                const size_t row = (size_t)u.pm * 256 + ai * 128 + wr * 64 + m * 16 + fr;
                const float rstd = rsqrtf(ssq_val(rs[ai][m]) * (1.0f / 1024.0f) + EPS);
                f32x4 v[2][2];
#pragma unroll
                for (int bj = 0; bj < 2; ++bj)
#pragma unroll
                    for (int n = 0; n < 2; ++n) v[bj][n] = acc[ai][bj][m][n] * rstd;
                if (t <= 2) {
                    const bool norm = (t < 2) || (wc < 2);
                    if (norm) {
                        float ss = 0.f;
#pragma unroll
                        for (int bj = 0; bj < 2; ++bj)
#pragma unroll
                            for (int n = 0; n < 2; ++n) ss += (v[bj][n][0] * v[bj][n][0] + v[bj][n][1] * v[bj][n][1]) + (v[bj][n][2] * v[bj][n][2] + v[bj][n][3] * v[bj][n][3]);
                        ss += shx(ss, 16, lane_); ss += shx(ss, 32, lane_);
                        const float r = rsqrtf(ss * (1.0f / 64.0f) + EPS);
#pragma unroll
                        for (int bj = 0; bj < 2; ++bj)
#pragma unroll
                            for (int n = 0; n < 2; ++n) v[bj][n] = v[bj][n] * r * cc[bj][n];
                    }
                    if (t < 2) { bf16* dst = TQ + row * 512 + 256 * t;
#pragma unroll
                        for (int bj = 0; bj < 2; ++bj) *(v4u*)(dst + lc0 + 32 * bj) = pack8(v[bj][0], v[bj][1]);
                    } else {
                        unsigned char* dst = (unsigned char*)TKV + row * 256;
#pragma unroll
                        for (int bj = 0; bj < 2; ++bj) { v2u w;
                            w.x = (unsigned)__builtin_amdgcn_cvt_pk_fp8_f32(v[bj][0][2], v[bj][0][3], __builtin_amdgcn_cvt_pk_fp8_f32(v[bj][0][0], v[bj][0][1], 0, false), true);
                            w.y = (unsigned)__builtin_amdgcn_cvt_pk_fp8_f32(v[bj][1][2], v[bj][1][3], __builtin_amdgcn_cvt_pk_fp8_f32(v[bj][1][0], v[bj][1][1], 0, false), true);
                            *(v2u*)(dst + lc0 + 32 * bj) = w; } }
                } else if (t == 3) {
#pragma unroll
                    for (int bj = 0; bj < 2; ++bj) *(v4u*)(TIQ + row * 256 + lc0 + 32 * bj) = pack8(v[bj][0], v[bj][1]);
                } else if (t == 4) {
                    if (wc == 0) {
#pragma unroll
                        for (int bj = 0; bj < 2; ++bj) *(v4u*)(TIK + row * 64 + lc0 + 32 * bj) = pack8(v[bj][0], v[bj][1]);
                    } else if (wc == 1 && fq == 0) {
                        *(f32x4*)(TIW + row * 4) = v[0][0];
                    }
                } else if (t <= 12) {
                    const int kind = (t - 5) >> 1, half = (t - 5) & 1;
                    bf16* base = kind == 0 ? THQ : kind == 1 ? THF : kind == 2 ? THI : THG;
                    if (kind == 1) {
#pragma unroll
                        for (int bj = 0; bj < 2; ++bj)
#pragma unroll
                            for (int n = 0; n < 2; ++n) { const f32x4 lbv = cc[bj][n];
#pragma unroll
                                for (int j = 0; j < 4; ++j) { const float z = fminf(fmaxf(v[bj][n][j], -60.f), 60.f); const float f = lbv[j] + (1.0f - lbv[j]) * sigmoidf_(z); v[bj][n][j] = __logf(f); } }
                    }
#pragma unroll
                    for (int bj = 0; bj < 2; ++bj) *(v4u*)(base + row * 512 + 256 * half + lc0 + 32 * bj) = pack8(v[bj][0], v[bj][1]);
                } else if (t <= 14) {
#pragma unroll
                    for (int bj = 0; bj < 2; ++bj) *(v4u*)(TCB + row * 512 + 256 * (t - 13) + lc0 + 32 * bj) = pack8(v[bj][0], v[bj][1]);
                } else {
                    *(v4u*)(TU + row * 512 + 128 * (t - 15) + 32 * wc + 8 * fq) = pack8(v[0][0] * v[1][0], v[0][1] * v[1][1]);
                }
            }
    }
};

struct EpiStoreBf16 {
    static constexpr bool PERM = true, AFTER_DRAIN = false;
    bf16* O; int ldc;
    __device__ __forceinline__ void operator()(const f32x4 (&acc)[2][2][4][2], const Unit& u, int wr, int wc, int fr_in, int fq_in) const {
        int fr = fr_in, fq = fq_in; asm volatile("" : "+v"(fr), "+v"(fq)); const int lane_ = fq * 16 + fr; (void)lane_;
#pragma unroll
        for (int ai = 0; ai < 2; ++ai)
#pragma unroll
            for (int m = 0; m < 4; ++m) { bf16* rowp = O + ((size_t)u.pm * 256 + ai * 128 + wr * 64 + m * 16 + fr) * ldc + u.pn * 256 + wc * 32 + 8 * fq;
#pragma unroll
                for (int bj = 0; bj < 2; ++bj) *(v4u*)(rowp + bj * 128) = pack8(acc[ai][bj][m][0], acc[ai][bj][m][1]); }
    }
};

template <bool FIRST> struct EpiGate {
    static constexpr bool PERM = true, AFTER_DRAIN = false;
    const u64* ssq; const bf16* Y; bf16* MX;
    __device__ __forceinline__ void operator()(const f32x4 (&acc)[2][2][4][2], const Unit& u, int wr, int wc, int fr_in, int fq_in) const {
        int fr = fr_in, fq = fq_in; asm volatile("" : "+v"(fr), "+v"(fq)); const int lane_ = fq * 16 + fr; (void)lane_;
        u64 rs[2][4];
#pragma unroll
        for (int ai = 0; ai < 2; ++ai)
#pragma unroll
            for (int m = 0; m < 4; ++m) rs[ai][m] = ssq[(size_t)u.pm * 256 + ai * 128 + wr * 64 + m * 16 + fr];
#pragma unroll
        for (int ai = 0; ai < 2; ++ai)
#pragma unroll
            for (int m = 0; m < 4; ++m) { const size_t row = (size_t)u.pm * 256 + ai * 128 + wr * 64 + m * 16 + fr;
                const float rstd = rsqrtf(ssq_val(rs[ai][m]) * (1.0f / 1024.0f) + EPS);
                const size_t off = row * 1024 + u.pn * 256 + wc * 32 + 8 * fq;
#pragma unroll
                for (int bj = 0; bj < 2; ++bj) { float y[8], o[8];
                    unpack8(*(const v4u*)(Y + off + bj * 128), y);
                    if (!FIRST) unpack8(*(const v4u*)(MX + off + bj * 128), o);
                    f32x4 r0, r1;
#pragma unroll
                    for (int j = 0; j < 4; ++j) { r0[j] = sigmoidf_(acc[ai][bj][m][0][j] * rstd) * y[j] + (FIRST ? 0.f : o[j]); r1[j] = sigmoidf_(acc[ai][bj][m][1][j] * rstd) * y[4 + j] + (FIRST ? 0.f : o[4 + j]); }
                    *(v4u*)(MX + off + bj * 128) = pack8(r0, r1); } }
    }
};

struct EpiResidual {
    static constexpr bool PERM = true, AFTER_DRAIN = false;
    bf16* XB; float* xout; u64* ssq_next; const u64* rs2;
    __device__ __forceinline__ void operator()(const f32x4 (&acc)[2][2][4][2], const Unit& u, int wr, int wc, int fr_in, int fq_in) const {
        int fr = fr_in, fq = fq_in; asm volatile("" : "+v"(fr), "+v"(fq)); const int lane_ = fq * 16 + fr; (void)lane_;
        u64 sc[2][4];
#pragma unroll
        for (int ai = 0; ai < 2; ++ai)
#pragma unroll
            for (int m = 0; m < 4; ++m) sc[ai][m] = rs2 ? rs2[(size_t)u.pm * 256 + ai * 128 + wr * 64 + m * 16 + fr] : 0ull;
        const size_t off0 = ((size_t)u.pm * 256 + wr * 64 + fr) * 1024 + u.pn * 256 + wc * 32 + 8 * fq;
        v4u xo[2][2][2];
#define ER_LOAD(buf_, bt_) do { _Pragma("unroll") for (int rr_ = 0; rr_ < 2; ++rr_) { const int q_ = 2 * (bt_) + rr_; const size_t o_ = off0 + (size_t)(128 * (q_ >> 2) + 16 * (q_ & 3)) * 1024; \
            _Pragma("unroll") for (int bj_ = 0; bj_ < 2; ++bj_) xo[buf_][rr_][bj_] = *(const v4u*)(XB + o_ + bj_ * 128); } } while (0)
        ER_LOAD(0, 0);
#pragma unroll
        for (int bt = 0; bt < 4; ++bt) {
            if (bt + 1 < 4) { if (bt & 1) ER_LOAD(0, bt + 1); else ER_LOAD(1, bt + 1); }
#pragma unroll
            for (int rr = 0; rr < 2; ++rr) { const int q = 2 * bt + rr, ai = q >> 2, m = q & 3;
                const size_t row = (size_t)u.pm * 256 + ai * 128 + wr * 64 + m * 16 + fr;
                const size_t off = off0 + (size_t)(128 * ai + 16 * m) * 1024;
                const float f = rs2 ? __builtin_amdgcn_rcpf(ssq_val(sc[ai][m]) * (1.0f / 1024.0f) + EPS) : 1.0f;
                float ss = 0.f;
#pragma unroll
                for (int bj = 0; bj < 2; ++bj) { float o[8]; unpack8(xo[bt & 1][rr][bj], o);
                    const f32x4 a = (f32x4){o[0], o[1], o[2], o[3]} + acc[ai][bj][m][0] * f;
                    const f32x4 b = (f32x4){o[4], o[5], o[6], o[7]} + acc[ai][bj][m][1] * f;
                    if (xout) { *(f32x4*)(xout + off + bj * 128) = a; *(f32x4*)(xout + off + bj * 128 + 4) = b; }
                    else *(v4u*)(XB + off + bj * 128) = pack8(a, b);
                    ss += (a[0] * a[0] + a[1] * a[1]) + (a[2] * a[2] + a[3] * a[3]) + (b[0] * b[0] + b[1] * b[1]) + (b[2] * b[2] + b[3] * b[3]); }
                if (ssq_next) { ss += shx(ss, 16, lane_); ss += shx(ss, 32, lane_); if (fq == 0) atomicAdd(ssq_next + row, (u64)ssq_fix(ss)); } }
        }
#undef ER_LOAD
    }
};

struct EpiMlpUp {
    static constexpr bool PERM = true, AFTER_DRAIN = false;
    bf16* H;
    __device__ __forceinline__ void operator()(const f32x4 (&acc)[2][2][4][2], const Unit& u, int wr, int wc, int fr_in, int fq_in) const {
        int fr = fr_in, fq = fq_in; asm volatile("" : "+v"(fr), "+v"(fq));
#pragma unroll
        for (int ai = 0; ai < 2; ++ai)
#pragma unroll
            for (int m = 0; m < 4; ++m) { const size_t row = (size_t)u.pm * 256 + ai * 128 + wr * 64 + m * 16 + fr;
                bf16* rowp = H + row * DFF + u.pn * 256 + wc * 32 + 8 * fq;
#pragma unroll
                for (int bj = 0; bj < 2; ++bj) { f32x4 a = acc[ai][bj][m][0], b = acc[ai][bj][m][1];
#pragma unroll
                    for (int j = 0; j < 4; ++j) { a[j] = fmaxf(a[j], 0.f); a[j] *= a[j]; b[j] = fmaxf(b[j], 0.f); b[j] *= b[j]; }
                    *(v4u*)(rowp + bj * 128) = pack8(a, b); } }
    }
};
}
#define XB_TMO      128
#define XB_XCNT(j)  (256  + 64 * (j))
#define XB_XSUB(j)  (1280 + 64 * (j))
#define XB_XGEN(j)  (2304 + 64 * (j))
#define XB_TOP      3328
#define XB_TOPGEN   3392
#define XCD_BAR_WORDS 3456
#define XB_SPIN_CAP (1u << 18)
#define LAS __attribute__((address_space(3)))

__device__ __forceinline__ unsigned xb_ld(unsigned* p)              { return __hip_atomic_load(p, __ATOMIC_RELAXED, __HIP_MEMORY_SCOPE_AGENT); }
__device__ __forceinline__ unsigned xb_add(unsigned* p, unsigned v) { return __hip_atomic_fetch_add(p, v, __ATOMIC_RELAXED, __HIP_MEMORY_SCOPE_AGENT); }
__device__ __forceinline__ unsigned xb_xcc_id() { return (unsigned)__builtin_amdgcn_s_getreg((3 << 11) | 20) & 0xFu; }
#define XB_SPIN(cond, bar) do { unsigned _sp = 0; while (cond) { __builtin_amdgcn_s_sleep(1); \
    if ((++_sp & 255u) == 0u) { if (xb_ld(&(bar)[XB_TMO])) break; if (_sp > XB_SPIN_CAP) { atomicAdd(&(bar)[XB_TMO], 1u); break; } } } } while (0)

struct XcdBarrier {
    unsigned* bar; unsigned x;
    volatile LAS unsigned* st;
};

__device__ __forceinline__ XcdBarrier xcd_barrier_post(unsigned* bar, volatile LAS unsigned* st) {
    XcdBarrier b; b.bar = bar; b.x = xb_xcc_id(); b.st = st;
    if (threadIdx.x == 0) (void)xb_add(&bar[XB_XCNT(b.x)], 1u);
    return b;
}
__device__ __forceinline__ void xcd_barrier_complete(unsigned* bar, unsigned x, unsigned& nloc, unsigned& nx) {
    const unsigned G = gridDim.x * gridDim.y * gridDim.z;
    unsigned sum, cnt, mine, sp = 0u;
    for (;;) {
        sum = 0u; cnt = 0u; mine = 0u;
#pragma unroll
        for (unsigned j = 0; j < 16; ++j) { const unsigned c = xb_ld(&bar[XB_XCNT(j)]); sum += c; cnt += (c > 0u) ? 1u : 0u; mine = (j == x) ? c : mine; }
        if (sum == G) break;
        __builtin_amdgcn_s_sleep(1);
        if ((++sp & 255u) == 0u) { if (xb_ld(&bar[XB_TMO])) break; if (sp > XB_SPIN_CAP) { atomicAdd(&bar[XB_TMO], 1u); break; } }
    }
    nloc = mine > 0u ? mine : 1u; nx = cnt > 0u ? cnt : 1u;
}

__device__ __forceinline__ void xcd_barrier(const XcdBarrier& b, const int tid_  ) {
    asm volatile("s_waitcnt vmcnt(0)" ::: "memory");
    __syncthreads();
    if (tid_ == 0) {
        unsigned* bar = b.bar;
        __builtin_amdgcn_s_waitcnt(0);
        unsigned nloc = b.st[0], nx = b.st[1];
        if (nloc == 0u) { xcd_barrier_complete(bar, b.x, nloc, nx); b.st[0] = nloc; b.st[1] = nx; }
        const unsigned old = xb_add(&bar[XB_XSUB(b.x)], 1u);
        const unsigned gen = old / nloc;
        if (old + 1u == (gen + 1u) * nloc) {
            __builtin_amdgcn_fence(__ATOMIC_RELEASE, "agent");
            asm volatile("s_waitcnt vmcnt(0)" ::: "memory");
            const unsigned og = xb_add(&bar[XB_TOP], 1u);
            const unsigned tg = og / nx;
            if (og + 1u == (tg + 1u) * nx) xb_add(&bar[XB_TOPGEN], 1u);
            else XB_SPIN(xb_ld(&bar[XB_TOPGEN]) == tg, bar);
            __builtin_amdgcn_fence(__ATOMIC_ACQUIRE, "agent");
            xb_add(&bar[XB_XGEN(b.x)], 1u);
            asm volatile("s_waitcnt vmcnt(0)" ::: "memory");
        } else {
            XB_SPIN(xb_ld(&bar[XB_XGEN(b.x)]) == gen, bar);
            __builtin_amdgcn_fence(__ATOMIC_ACQUIRE, "agent");
            asm volatile("s_waitcnt vmcnt(0)" ::: "memory");
        }
    }
    __syncthreads();
}


__device__ __forceinline__ int opaque_tid(int wv) { int t; asm volatile("v_mbcnt_lo_u32_b32 %0, -1, 0\n\tv_mbcnt_hi_u32_b32 %0, -1, %0\n\tv_lshl_add_u32 %0, %1, 6, %0" : "=&v"(t) : "s"(wv)); return t; }

__device__ __forceinline__ int inproj_src_col(int t, int p) {
    const int lc = 64 * ((p >> 5) & 3) + 32 * (p >> 7) + (p & 31);
    if (t <= 1) return 256 * t + lc;
    if (t == 2) return lc < 128 ? 512 + lc : 640 + (lc - 128);
    if (t == 3) return 768 + lc;
    if (t == 4) return lc < 64 ? 1024 + lc : (lc < 68 ? 1088 + (lc - 64) : -1);
    if (t <= 6) return 1092 + 256 * (t - 5) + lc;
    if (t <= 8) return 1604 + 256 * (t - 7) + lc;
    if (t <= 10) return 2116 + 256 * (t - 9) + lc;
    if (t <= 12) return 2628 + 256 * (t - 11) + lc;
    if (t <= 14) return 3140 + 256 * (t - 13) + lc;
    const int ct = t - 15, which = (lc >> 5) & 1, chn = 128 * ct + 32 * (lc >> 6) + (lc & 31);
    return (which ? 4164 : 3652) + chn;
}
__device__ __forceinline__ void cvt_item(const float* W, int ldw, int src, const float* gain, bf16* out, int K, int n0, int k0, LAS float* scr, int lane) {
    float v[32];
#pragma unroll
    for (int i = 0; i < 32; ++i) { const int kk = 2 * i + (lane >> 5); v[i] = (src >= 0) ? W[(size_t)(k0 + kk) * ldw + src] : 0.f; }
    if (gain) {
#pragma unroll
        for (int i = 0; i < 32; ++i) v[i] *= gain[k0 + 2 * i + (lane >> 5)];
    }
#pragma unroll
    for (int i = 0; i < 32; ++i) scr[(2 * i + (lane >> 5)) * 33 + (lane & 31)] = v[i];
    LDS_WAIT();
    const int c = lane & 7;
#pragma unroll
    for (int j = 0; j < 4; ++j) { const int n = (lane >> 3) + 8 * j; const LAS float* s = scr + (8 * c) * 33 + n;
        v4u o; o.x = pk2(s[0 * 33], s[1 * 33]); o.y = pk2(s[2 * 33], s[3 * 33]); o.z = pk2(s[4 * 33], s[5 * 33]); o.w = pk2(s[6 * 33], s[7 * 33]);
        *(v4u*)(out + (size_t)(n0 + n) * K + k0 + 8 * c) = o; }
    LDS_WAIT();
}
__device__ __forceinline__ void phase_prologue(ArgsP a, LAS unsigned char* lds, int G, int bid, int wv) {
    const int tid = opaque_tid(wv), lane = tid & 63, wave = tid >> 6;
    LAS float* scr = (LAS float*)(lds + wave * 16384);
    const int gw = bid * NWAVES + wave, NGW = G * NWAVES;
    unsigned char* ws = a->ws;
    constexpr int I0 = 16 * 152, I1 = 16 * 96, I2 = 8 * 32, I5 = 16 * 32, I6 = 16 * 128, I7 = 64 * 32;
    constexpr int ILAYER = I0 + I1 + 3 * I2 + I5 + I6 + I7;
    for (int it = gw; it < NLAYER * ILAYER; it += NGW) {
        const int l = it / ILAYER; int r = it % ILAYER;
        unsigned char* wl = ws + WS_W + (size_t)l * W_LAYER;
        const float* win = a->in[4] + (size_t)l * 1024 * DIN;
        if (r < I0) { const int kb = r / 152, nb = r % 152, n = nb * 32 + (lane & 31);
            cvt_item(win, DIN, inproj_src_col(n >> 8, n & 255), a->in[3] + l * 1024, (bf16*)(wl + W_IN), 1024, nb * 32, kb * 64, scr, lane); continue; } r -= I0;
        if (r < I1) { const int kb = r / 96, nb = r % 96;
            cvt_item(win, DIN, 4676 + nb * 32 + (lane & 31), a->in[3] + l * 1024, (bf16*)(wl + W_G), 1024, nb * 32, kb * 64, scr, lane); continue; } r -= I1;
        if (r < 3 * I2) { const int which = r / I2; r %= I2; const int kb = r / 32, nb = r % 32;
            cvt_item(a->in[9 + which] + (size_t)l * 512 * 1024, 1024, nb * 32 + (lane & 31), nullptr, (bf16*)(wl + W_UA + which * MiB), 512, nb * 32, kb * 64, scr, lane); continue; } r -= 3 * I2;
        if (r < I5) { const int kb = r / 32, nb = r % 32;
            cvt_item(a->in[12] + (size_t)l * 1024 * 1024, 1024, nb * 32 + (lane & 31), nullptr, (bf16*)(wl + W_O), 1024, nb * 32, kb * 64, scr, lane); continue; } r -= I5;
        if (r < I6) { const int kb = r / 128, nb = r % 128;
            cvt_item(a->in[14] + (size_t)l * 1024 * 4096, 4096, nb * 32 + (lane & 31), a->in[13] + l * 1024, (bf16*)(wl + W_UP), 1024, nb * 32, kb * 64, scr, lane); continue; } r -= I6;
        { const int kb = r / 32, nb = r % 32;
            cvt_item(a->in[15] + (size_t)l * 4096 * 1024, 1024, nb * 32 + (lane & 31), nullptr, (bf16*)(wl + W_DN), 4096, nb * 32, kb * 64, scr, lane); }
    }
    u64* ssq = (u64*)(ws + WS_SSQ);
    bf16* XB = (bf16*)(ws + WS_XB);
    for (int m0 = gw * 4; m0 < MTOK; m0 += NGW * 4) {
        f32x4 v[4][4];
#pragma unroll
        for (int rr = 0; rr < 4; ++rr) { const f32x4* xr = (const f32x4*)(a->in[0] + (size_t)(m0 + rr) * DM) + lane;
#pragma unroll
            for (int j = 0; j < 4; ++j) v[rr][j] = xr[64 * j]; }
#pragma unroll
        for (int rr = 0; rr < 4; ++rr) { const int m = m0 + rr; float s = 0.f;
#pragma unroll
            for (int j = 0; j < 4; ++j) s += (v[rr][j][0] * v[rr][j][0] + v[rr][j][1] * v[rr][j][1]) + (v[rr][j][2] * v[rr][j][2] + v[rr][j][3] * v[rr][j][3]);
            s = wave_sum(s, lane);
            v2u* o8 = (v2u*)(XB + (size_t)m * DM) + lane;
#pragma unroll
            for (int j = 0; j < 4; ++j) { v2u w; w.x = pk2(v[rr][j][0], v[rr][j][1]); w.y = pk2(v[rr][j][2], v[rr][j][3]); o8[64 * j] = w; }
            if (lane == 0) { ssq[m] = (u64)(s * 65536.0f + 0.5f); ssq[MTOK + m] = 0ull; ssq[2 * MTOK + m] = 0ull; ssq[3 * MTOK + m] = 0ull; } }
    }
    float* lb = (float*)(ws + WS_LB);
    for (int c = bid * NTHREADS + tid; c < 512; c += G * NTHREADS) { lb[c] = 0.f; lb[512 + c] = sigmoidf_(a->in[2][512 + c] - a->in[2][c]); }
}

__device__ __forceinline__ int wave_incl_scan(int x) {
    x += __builtin_amdgcn_update_dpp(0, x, 0x111, 0xf, 0xf, false);
    x += __builtin_amdgcn_update_dpp(0, x, 0x112, 0xf, 0xf, false);
    x += __builtin_amdgcn_update_dpp(0, x, 0x114, 0xf, 0xf, false);
    x += __builtin_amdgcn_update_dpp(0, x, 0x118, 0xf, 0xf, false);
    x += __builtin_amdgcn_update_dpp(0, x, 0x142, 0xa, 0xf, false);
    x += __builtin_amdgcn_update_dpp(0, x, 0x143, 0xc, 0xf, false);
    return x;
}
__device__ __forceinline__ int wave_suffix_sum(int s) { const int p = wave_incl_scan(s); return __builtin_amdgcn_readlane(p, 63) - p + s; }
constexpr int IDX_CAP = 1024;
__device__ __forceinline__ int select_top256(LAS int* buf, int n, LAS unsigned* hist, int lane) {
    int e[16];
#pragma unroll
    for (int i = 0; i < 16; ++i) e[i] = (lane + 64 * i < n) ? buf[lane + 64 * i] : (int)0x80000000;
    unsigned prefix = 0; int need = 256;
#pragma unroll 1
    for (int round = 0; round < 4; ++round) {
        const int shift = 24 - 8 * round;
        *(LAS v4u*)(hist + 4 * lane) = (v4u){0u, 0u, 0u, 0u};
        LDS_WAIT();
#pragma unroll
        for (int i = 0; i < 16; ++i) { const unsigned uu = (unsigned)e[i] ^ 0x80000000u;
            const bool match = (lane + 64 * i < n) && (round == 0 || (uu >> (shift + 8)) == prefix);
            if (match) __hip_atomic_fetch_add(hist + ((uu >> shift) & 255u), 1u, __ATOMIC_RELAXED, __HIP_MEMORY_SCOPE_WORKGROUP); }
        LDS_WAIT();
        const v4u h4 = *(LAS v4u*)(hist + 4 * lane);
        LDS_WAIT();
        const int s = (int)(h4.x + h4.y + h4.z + h4.w);
        const int S = wave_suffix_sum(s);
        const unsigned long long bal = __ballot(S >= need);
        const int L = __builtin_amdgcn_readfirstlane(63 - __builtin_clzll(bal | 1ull));
        const int SL = __builtin_amdgcn_readlane(S, L), hx = __builtin_amdgcn_readlane((int)h4.x, L), hy = __builtin_amdgcn_readlane((int)h4.y, L), hz = __builtin_amdgcn_readlane((int)h4.z, L), hw = __builtin_amdgcn_readlane((int)h4.w, L);
        const int above = SL - (hx + hy + hz + hw);
        int b;
        const int c3 = above + hw, c2 = c3 + hz, c1 = c2 + hy;
        if (c3 >= need) { b = 4 * L + 3; need -= above; }
        else if (c2 >= need) { b = 4 * L + 2; need -= c3; }
        else if (c1 >= need) { b = 4 * L + 1; need -= c2; }
        else { b = 4 * L; need -= c1; }
        prefix = (prefix << 8) | (unsigned)b;
    }
    int base = 0;
#pragma unroll
    for (int i = 0; i < 16; ++i) { const bool keep = (lane + 64 * i < n) && (((unsigned)e[i] ^ 0x80000000u) >= prefix);
        const unsigned long long bal = __ballot(keep);
        const int pos = base + __popcll(bal & ((1ull << lane) - 1ull));
        if (keep) buf[pos] = e[i];
        base += __popcll(bal); }
    LDS_WAIT();
    return (int)(prefix ^ 0x80000000u);
}

__device__ __forceinline__ void emit_selected(LAS int* kb, int n, LAS unsigned* bm, unsigned short* dst, int lane) {
    int pos[4];
#pragma unroll
    for (int i = 0; i < 4; ++i) { const int k = lane + 64 * i; pos[i] = (k < n) ? (int)(8191u - ((unsigned)kb[k] & 0x1fffu)) : -1; }
    *(LAS v4u*)(bm + 4 * lane) = (v4u){0u, 0u, 0u, 0u};
    LDS_WAIT();
#pragma unroll
    for (int i = 0; i < 4; ++i) if (pos[i] >= 0) __hip_atomic_fetch_or(bm + (pos[i] >> 5), 1u << (pos[i] & 31), __ATOMIC_RELAXED, __HIP_MEMORY_SCOPE_WORKGROUP);
    LDS_WAIT();
    const v4u w = *(const LAS v4u*)(bm + 4 * lane);
    const int c0 = __popc(w.x), c1 = __popc(w.y), c2 = __popc(w.z), c = c0 + c1 + c2 + __popc(w.w);
    const int incl = wave_incl_scan(c);
    const unsigned o = (unsigned)(incl - c);
    LAS unsigned* pre = (LAS unsigned*)kb;
    *(LAS v4u*)(pre + 4 * lane) = (v4u){o, o + (unsigned)c0, o + (unsigned)(c0 + c1), o + (unsigned)(c0 + c1 + c2)};
    LDS_WAIT();
#pragma unroll
    for (int i = 0; i < 4; ++i) { const int k = lane + 64 * i;
        if (pos[i] >= 0) { const int wd = pos[i] >> 5; const unsigned rank = pre[wd] + (unsigned)__popc(bm[wd] & ((1u << (pos[i] & 31)) - 1u)); dst[rank] = (unsigned short)pos[i]; }
        if (k >= n) dst[k] = (unsigned short)0; }
    LDS_WAIT();
}
__device__ __forceinline__ void indexer_group_slow(LAS unsigned char* lds, const bf16* TIQ, const bf16* TIK, const float* TIW, unsigned short* SEL, int b, int qg, int wv) {
    const int tid = opaque_tid(wv), lane = tid & 63, wave = __builtin_amdgcn_readfirstlane(tid >> 6);
    LAS int* buf = (LAS int*)lds;
    LAS int* cnt = (LAS int*)(lds + LDS_AUX);
    LAS int* thr = cnt + 32;
    LAS int* flg = cnt + 64;
    LAS unsigned* hist = (LAS unsigned*)(lds + LDS_AUX + 1024) + wave * 256;
    const int j = lane & 31, hh = lane >> 5;
    const int t0 = qg * 32, nt = qg + 1;
    const size_t rowbase = (size_t)b * SEQ;
    if (tid < 32) { cnt[tid] = 0; thr[tid] = (int)0x80000000; flg[tid & 1] = 0; }
    bf16x8 bq[4][4];
    {   const bf16* qp = TIQ + (rowbase + t0 + j) * 256 + hh * 8;
#pragma unroll
        for (int h = 0; h < 4; ++h)
#pragma unroll
            for (int ks = 0; ks < 4; ++ks) bq[h][ks] = *(const bf16x8*)(qp + h * 64 + ks * 16); }
    const f32x4 wgt = *(const f32x4*)(TIW + (rowbase + t0 + j) * 4);
    __syncthreads();
    LAS int* mybuf = buf + j * IDX_CAP;
    for (int it = 0; it * 8 < nt; ++it) {
        const int tile = it * 8 + wave;
        if (tile < nt) {
            const bf16* kp = TIK + (rowbase + tile * 32 + j) * 64 + hh * 8;
            bf16x8 ka[4];
#pragma unroll
            for (int ks = 0; ks < 4; ++ks) ka[ks] = *(const bf16x8*)(kp + ks * 16);
            f32x16 acc[4];
#pragma unroll
            for (int h = 0; h < 4; ++h) {
#pragma unroll
                for (int r = 0; r < 16; ++r) acc[h][r] = 0.f;
#pragma unroll
                for (int ks = 0; ks < 4; ++ks) acc[h] = __builtin_amdgcn_mfma_f32_32x32x16_bf16(ka[ks], bq[h][ks], acc[h], 0, 0, 0);
            }
            const int th = thr[j];
            const int tq = t0 + j;
            int keys[16]; unsigned mask = 0u;
#pragma unroll
            for (int r = 0; r < 16; ++r) {
                const int s = tile * 32 + 8 * (r >> 2) + 4 * hh + (r & 3);
                const float sc = __builtin_fmaf(wgt[3], __int_as_float(max(__float_as_int(acc[3][r]), 0)), __builtin_fmaf(wgt[2], __int_as_float(max(__float_as_int(acc[2][r]), 0)),
                                  __builtin_fmaf(wgt[1], __int_as_float(max(__float_as_int(acc[1][r]), 0)), wgt[0] * __int_as_float(max(__float_as_int(acc[0][r]), 0)))));
                const int si = __float_as_int(sc);
                const int o = si ^ ((si >> 31) & 0x7fffffff);
                const int key = (o & ~0x1fff) | (8191 - s);
                keys[r] = key;
                if (s <= tq && key > th) mask |= (1u << r);
            }
            if (mask) {
                int pos = __hip_atomic_fetch_add(cnt + j, __popc(mask), __ATOMIC_RELAXED, __HIP_MEMORY_SCOPE_WORKGROUP);
#pragma unroll
                for (int r = 0; r < 16; ++r) if (mask & (1u << r)) { mybuf[pos] = keys[r]; ++pos; }
            }
        }
        __syncthreads();
        if (tid < 32 && cnt[tid] > IDX_CAP - 256) flg[it & 1] = 1;
        if (tid == 0) flg[(it + 1) & 1] = 0;
        __syncthreads();
        if (flg[it & 1]) {
            for (int q = wave; q < 32; q += 8) { const int n = cnt[q];
                if (n > 512) { const int tnew = select_top256(buf + q * IDX_CAP, n, hist, lane); if (lane == 0) { cnt[q] = 256; thr[q] = tnew; } } }
            __syncthreads();
        }
    }
    for (int q = wave; q < 32; q += 8) {
        int n = cnt[q];
        if (n > 256) { (void)select_top256(buf + q * IDX_CAP, n, hist, lane); n = 256; }
        emit_selected(buf + q * IDX_CAP, n, hist, SEL + (rowbase + t0 + q) * 256, lane);
    }
    __syncthreads();
}
typedef float f32x2v __attribute__((ext_vector_type(2)));
template <int PASS>
__device__ __forceinline__ void idx_pass(const bf16* TIK, size_t rowbase, int t0, int nt, int wave, int j, int hh, const bf16x8 (&bq)[4][4], const f32x4 wgt,
                                         LAS unsigned* hist, LAS int* buf, LAS int* cnt, int thr, unsigned char* scr) {
    bf16x8 ka[4];
    int tile = wave;
    if (tile < nt) { const bf16* kp = TIK + (rowbase + tile * 32 + j) * 64 + hh * 8;
#pragma unroll
        for (int ks = 0; ks < 4; ++ks) ka[ks] = *(const bf16x8*)(kp + ks * 16); }
    const int tq = t0 + j;
    const int hbase = j * 4096 + 2048;
    LAS int* mybuf = buf + j * IDX_CAP;
    const f32x2v w0 = (f32x2v){wgt[0], wgt[0]}, w1 = (f32x2v){wgt[1], wgt[1]}, w2 = (f32x2v){wgt[2], wgt[2]}, w3 = (f32x2v){wgt[3], wgt[3]};
#pragma unroll 1
    for (; tile < nt; tile += 8) {
        f32x16 acc[4];
#pragma unroll
        for (int h = 0; h < 4; ++h) {
#pragma unroll
            for (int r = 0; r < 16; ++r) acc[h][r] = 0.f;
#pragma unroll
            for (int ks = 0; ks < 4; ++ks) acc[h] = __builtin_amdgcn_mfma_f32_32x32x16_bf16(ka[ks], bq[h][ks], acc[h], 0, 0, 0);
        }
        if (tile + 8 < nt) { const bf16* kp = TIK + (rowbase + (tile + 8) * 32 + j) * 64 + hh * 8;
#pragma unroll
            for (int ks = 0; ks < 4; ++ks) ka[ks] = *(const bf16x8*)(kp + ks * 16); }
        const int lowb = 8191 - tile * 32 - 4 * hh;
        const int lim = tq - tile * 32 - 4 * hh;
        unsigned mask = 0u; unsigned pk[8];
#pragma unroll
        for (int r2 = 0; r2 < 8; ++r2) {
            const int ra = 2 * r2, rb = 2 * r2 + 1; int opair[2];
#define IDX_RELU(x_) __int_as_float(max(__float_as_int(x_), 0))
            f32x2v sc;
            {   float r0 = IDX_RELU(acc[0][ra]), r1 = IDX_RELU(acc[1][ra]), r2 = IDX_RELU(acc[2][ra]), r3 = IDX_RELU(acc[3][ra]), t;
                asm("v_mul_f32 %0, %1, %2" : "=v"(t) : "v"(wgt[0]), "v"(r0)); asm("v_fmac_f32 %0, %1, %2" : "+v"(t) : "v"(wgt[1]), "v"(r1));
                asm("v_fmac_f32 %0, %1, %2" : "+v"(t) : "v"(wgt[2]), "v"(r2)); asm("v_fmac_f32 %0, %1, %2" : "+v"(t) : "v"(wgt[3]), "v"(r3)); sc.x = t; }
            {   float r0 = IDX_RELU(acc[0][rb]), r1 = IDX_RELU(acc[1][rb]), r2 = IDX_RELU(acc[2][rb]), r3 = IDX_RELU(acc[3][rb]), t;
                asm("v_mul_f32 %0, %1, %2" : "=v"(t) : "v"(wgt[0]), "v"(r0)); asm("v_fmac_f32 %0, %1, %2" : "+v"(t) : "v"(wgt[1]), "v"(r1));
                asm("v_fmac_f32 %0, %1, %2" : "+v"(t) : "v"(wgt[2]), "v"(r2)); asm("v_fmac_f32 %0, %1, %2" : "+v"(t) : "v"(wgt[3]), "v"(r3)); sc.y = t; }
#undef IDX_RELU
#pragma unroll
            for (int e = 0; e < 2; ++e) { const int r = 2 * r2 + e; const int ro = 8 * (r >> 2) + (r & 3);
                const int si = __float_as_int(e ? sc.y : sc.x);
                const int o = si ^ ((si >> 31) & 0x7fffffff); opair[e] = o;
                const int key = (o & ~0x1fff) | (lowb - ro);
                if (PASS == 1) { const unsigned val = (ro <= lim) ? (unsigned)__builtin_amdgcn_ubfe(o, 21, 1) * 0xffffu + 1u : 0u;
                    __hip_atomic_fetch_add((LAS unsigned*)((LAS unsigned char*)hist + hbase + (__builtin_amdgcn_sbfe(o, 22, 10) << 2)), val, __ATOMIC_RELAXED, __HIP_MEMORY_SCOPE_WORKGROUP); }
                else { acc[0][r] = __int_as_float(key); if (ro <= lim && key >= thr) mask |= (1u << r); } }
            if (PASS == 1) pk[r2] = __builtin_amdgcn_perm((unsigned)opair[1], (unsigned)opair[0], 0x07060302u);
        }
        if (PASS == 1) {
            unsigned char* sp = scr + (size_t)tile * 2048 + (size_t)(hh * 32 + j) * 16;
            *(v4u*)sp = (v4u){pk[0], pk[1], pk[2], pk[3]}; *(v4u*)(sp + 1024) = (v4u){pk[4], pk[5], pk[6], pk[7]}; }
        if (PASS == 2 && mask) {
            int pos = __hip_atomic_fetch_add(cnt + j, __popc(mask), __ATOMIC_RELAXED, __HIP_MEMORY_SCOPE_WORKGROUP);
#pragma unroll
            for (int r = 0; r < 16; ++r) if (mask & (1u << r)) { if (pos < IDX_CAP) mybuf[pos] = __float_as_int(acc[0][r]); ++pos; }
        }
    }
}
__device__ __forceinline__ void idx_pass2(const unsigned char* scr, int t0, int nt, int wave, int j, int hh, LAS int* buf, LAS int* cnt, int thr) {
    int tile = wave;
    if (tile >= nt) return;
    const int tq = t0 + j;
    LAS int* mybuf = buf + j * IDX_CAP;
    const unsigned char* sp0 = scr + (size_t)(hh * 32 + j) * 16;
    v4u qa = *(const v4u*)(sp0 + (size_t)tile * 2048), qb = *(const v4u*)(sp0 + (size_t)tile * 2048 + 1024);
#pragma unroll 1
    for (; tile < nt; tile += 8) {
        const v4u ca = qa, cb = qb;
        if (tile + 8 < nt) { qa = *(const v4u*)(sp0 + (size_t)(tile + 8) * 2048); qb = *(const v4u*)(sp0 + (size_t)(tile + 8) * 2048 + 1024); }
        const int lowb = 8191 - tile * 32 - 4 * hh;
        const int lim = tq - tile * 32 - 4 * hh;
        int key[16]; unsigned mask = 0u;
#pragma unroll
        for (int r = 0; r < 16; ++r) { const int ro = 8 * (r >> 2) + (r & 3); const unsigned w = (r < 8) ? ca[r >> 1] : cb[(r - 8) >> 1];
            key[r] = (int)(((r & 1) ? (w & 0xffff0000u) : (w << 16)) | (unsigned)(lowb - ro));
            if (ro <= lim && key[r] >= thr) mask |= (1u << r); }
        if (mask) {
            int pos = __hip_atomic_fetch_add(cnt + j, __popc(mask), __ATOMIC_RELAXED, __HIP_MEMORY_SCOPE_WORKGROUP);
#pragma unroll
            for (int r = 0; r < 16; ++r) if (mask & (1u << r)) { if (pos < IDX_CAP) mybuf[pos] = key[r]; ++pos; }
        }
    }
}
__device__ __forceinline__ int idx_find_bin(const LAS unsigned* hq, int lane, int& ncand) {
    v4u w[4];
#pragma unroll
    for (int i = 0; i < 4; ++i) w[i] = *(const LAS v4u*)(hq + 16 * lane + 4 * i);
    int s = 0;
#pragma unroll
    for (int i = 0; i < 4; ++i)
#pragma unroll
        for (int c = 0; c < 4; ++c) s += (int)(w[i][c] & 0xffffu) + (int)(w[i][c] >> 16);
    const int S = wave_suffix_sum(s);
    const int total = __builtin_amdgcn_readlane(S, 0);
    const unsigned long long bal = __ballot(S >= 256);
    const int L = __builtin_amdgcn_readfirstlane(63 - __builtin_clzll(bal | 1ull));
    int cum = S - s, rbin = 0, rcand = 0; bool found = false;
#pragma unroll
    for (int bb = 31; bb >= 0; --bb) { const int c = (int)((w[bb >> 3][(bb >> 1) & 3] >> (16 * (bb & 1))) & 0xffffu);
        cum += c; if (!found && cum >= 256) { found = true; rbin = 32 * lane + bb; rcand = cum; } }
    rbin = __builtin_amdgcn_readlane(rbin, L); rcand = __builtin_amdgcn_readlane(rcand, L);
    if (total <= 256) { ncand = total; return 0; }
    ncand = rcand; return rbin;
}
__device__ __forceinline__ void select_in_bin(LAS int* buf, int n_in, int binkey, LAS unsigned* hist, int lane) {
    const int n = __builtin_amdgcn_readfirstlane(n_in);
    int e[16]; int cab = 0;
#pragma unroll
    for (int i = 0; i < 16; ++i) { e[i] = (int)0x80000000; if (64 * i < n) { e[i] = (lane + 64 * i < n) ? buf[lane + 64 * i] : (int)0x80000000; cab += __popcll(__ballot((lane + 64 * i < n) && (e[i] >> 21) > binkey)); } }
    int need = 256 - cab; unsigned prefix = 0u;
#pragma unroll 1
    for (int round = 0; round < 3; ++round) {
        const int shift = 14 - 7 * round;
        if (lane < 32) *(LAS v4u*)(hist + 4 * lane) = (v4u){0u, 0u, 0u, 0u};
        LDS_WAIT();
#pragma unroll
        for (int i = 0; i < 16; ++i) if (64 * i < n) { const unsigned lowv = (unsigned)e[i] & 0x1fffffu;
            const bool match = ((e[i] >> 21) == binkey) && (lane + 64 * i < n) && (round == 0 || (lowv >> (shift + 7)) == prefix);
            if (match) __hip_atomic_fetch_add(hist + ((lowv >> shift) & 127u), 1u, __ATOMIC_RELAXED, __HIP_MEMORY_SCOPE_WORKGROUP); }
        LDS_WAIT();
        v4u h4 = (v4u){0u, 0u, 0u, 0u};
        if (lane < 32) h4 = *(LAS v4u*)(hist + 4 * lane);
        LDS_WAIT();
        const int s = (int)(h4.x + h4.y + h4.z + h4.w);
        const int S = wave_suffix_sum(s);
        const unsigned long long bal = __ballot(S >= need);
        const int L = __builtin_amdgcn_readfirstlane(63 - __builtin_clzll(bal | 1ull));
        const int SL = __builtin_amdgcn_readlane(S, L), hx = __builtin_amdgcn_readlane((int)h4.x, L), hy = __builtin_amdgcn_readlane((int)h4.y, L), hz = __builtin_amdgcn_readlane((int)h4.z, L), hw = __builtin_amdgcn_readlane((int)h4.w, L);
        const int above = SL - (hx + hy + hz + hw);
        int bsel; const int c3 = above + hw, c2 = c3 + hz, c1 = c2 + hy;
        if (c3 >= need) { bsel = 4 * L + 3; need -= above; }
        else if (c2 >= need) { bsel = 4 * L + 2; need -= c3; }
        else if (c1 >= need) { bsel = 4 * L + 1; need -= c2; }
        else { bsel = 4 * L; need -= c1; }
        prefix = (prefix << 7) | (unsigned)bsel;
    }
    int base = 0;
#pragma unroll
    for (int i = 0; i < 16; ++i) if (64 * i < n) { const int hb = e[i] >> 21; const bool keep = (lane + 64 * i < n) && (hb > binkey || (hb == binkey && ((unsigned)e[i] & 0x1fffffu) >= prefix));
        const unsigned long long bal = __ballot(keep);
        const int pos = base + __popcll(bal & ((1ull << lane) - 1ull));
        if (keep) buf[pos] = e[i];
        base += __popcll(bal); }
    LDS_WAIT();
}
__device__ __forceinline__ bool indexer_group(LAS unsigned char* lds, const bf16* TIQ, const bf16* TIK, const float* TIW, unsigned short* SEL, unsigned char* scr, int b, int qg, int wv) {
    const int tid = opaque_tid(wv), lane = tid & 63, wave = __builtin_amdgcn_readfirstlane(tid >> 6);
    LAS unsigned* hist = (LAS unsigned*)lds;
    LAS int* buf = (LAS int*)lds;
    LAS int* cnt = (LAS int*)(lds + LDS_AUX);
    LAS int* thrq = cnt + 32;
    LAS int* fbk = cnt + 66;
    LAS unsigned* shist = (LAS unsigned*)(lds + LDS_AUX + 1024) + wave * 256;
    const int j = lane & 31, hh = lane >> 5;
    const int t0 = qg * 32, nt = qg + 1;
    const size_t rowbase = (size_t)b * SEQ;
#pragma unroll
    for (int i = 0; i < 16; ++i) *(LAS v4u*)(lds + (size_t)(tid + NTHREADS * i) * 16) = (v4u){0u, 0u, 0u, 0u};
    if (tid < 32) cnt[tid] = 0;
    if (tid == 0) fbk[0] = 0;
    bf16x8 bq[4][4];
    {   const bf16* qp = TIQ + (rowbase + t0 + j) * 256 + hh * 8;
#pragma unroll
        for (int h = 0; h < 4; ++h)
#pragma unroll
            for (int ks = 0; ks < 4; ++ks) bq[h][ks] = *(const bf16x8*)(qp + h * 64 + ks * 16); }
    const f32x4 wgt = *(const f32x4*)(TIW + (rowbase + t0 + j) * 4);
    __syncthreads();
    idx_pass<1>(TIK, rowbase, t0, nt, wave, j, hh, bq, wgt, hist, buf, cnt, 0, scr);
    __syncthreads();
    for (int q = wave; q < 32; q += 8) { int ncand; const int bin = idx_find_bin(hist + q * 1024, lane, ncand);
        if (lane == 0) { thrq[q] = (bin == 0) ? (int)0x80000000 : (int)((unsigned)(bin - 1024) << 21); if (ncand > IDX_CAP) fbk[0] = 1; } }
    __syncthreads();
    if (fbk[0]) { __syncthreads(); return true; }
    asm volatile("s_waitcnt vmcnt(0)" ::: "memory");
    idx_pass2(scr, t0, nt, wave, j, hh, buf, cnt, thrq[j]);
    __syncthreads();
    for (int q = wave; q < 32; q += 8) {
        int n = cnt[q]; n = n < IDX_CAP ? n : IDX_CAP;
        if (n > 256) { select_in_bin(buf + q * IDX_CAP, n, thrq[q] >> 21, shist, lane); n = 256; }
        emit_selected(buf + q * IDX_CAP, n, shist, SEL + (rowbase + t0 + q) * 256, lane);
    }
    __syncthreads();
    return false;
}
__device__ __forceinline__ void phase_indexer(ArgsP a, LAS unsigned char* lds, int l, int G, int bid, int wv) {
    unsigned char* ws = a->ws;
    const bf16* TIQ = (const bf16*)(ws + A_TIQ); const bf16* TIK = (const bf16*)(ws + A_TIK); const float* TIW = (const float*)(ws + A_TIW); unsigned short* SEL = (unsigned short*)(ws + A_SEL);
    const int b = bid & 7;
    unsigned* ticket = (unsigned*)(ws + WS_CTL) + CW_TICKET + (32 + l * 8 + b) * 64;
    volatile LAS int* tks = (volatile LAS int*)(lds + MISC_OFF + 128);
    const int tid0 = opaque_tid(wv);
#pragma unroll 1
    for (;;) {
        if (tid0 == 0) tks[0] = (int)__hip_atomic_fetch_add(ticket, 1u, __ATOMIC_RELAXED, __HIP_MEMORY_SCOPE_AGENT);
        __syncthreads();
        const int tk = __builtin_amdgcn_readfirstlane(tks[0]);
        __syncthreads();
        if (tk >= SEQ / 32) break;
        const int qg = SEQ / 32 - 1 - tk;
        const bool slow = indexer_group(lds, TIQ, TIK, TIW, SEL, ws + A_SCR + (size_t)bid * 524288, b, qg, wv);
        if (slow) indexer_group_slow(lds, TIQ, TIK, TIW, SEL, b, qg, wv);
    }
}

constexpr int HPRP = 272;
constexpr int HPO_LF = 0, HPO_Q = 17408, HPO_I = 34816, HPO_TOT = 52224, HPO_QD = 54272, HPO_QX = HPO_QD + 64 * HPRP, HPO_KB = HPO_QX + 48 * HPRP, HPO_KD = HPO_KB + 48 * HPRP;
__device__ __forceinline__ void phase_hgrn_pre(ArgsP a, LAS unsigned char* lds, int G, int bid, int wv) {
    unsigned char* ws = a->ws;
    bf16* THQ = (bf16*)(ws + A_THQ); bf16* THF = (bf16*)(ws + A_THF); bf16* THI = (bf16*)(ws + A_THI); bf16* HATTN = (bf16*)(ws + A_HATTN); float* HDEC = (float*)(ws + A_HDEC);
    const int tid = opaque_tid(wv), lane = tid & 63, wave = tid >> 6, fr = lane & 15, fq = lane >> 4;
    const int sa = tid >> 7, d = tid & 127;
    LAS float* sTot = (LAS float*)(lds + HPO_TOT);
    constexpr int NU = (MTOK / 64) * 4;
    v4u ld[6];
#define HP_LOAD(u_) do { const int h_ = (u_) & 3; const size_t r0_ = (size_t)((u_) >> 2) * 64; _Pragma("unroll") for (int i_ = 0; i_ < 2; ++i_) { const int p_ = tid + NTHREADS * i_; \
        const size_t o_ = (r0_ + (p_ >> 4)) * 512 + h_ * 128 + (p_ & 15) * 8; ld[i_] = *(const v4u*)(THF + o_); ld[2 + i_] = *(const v4u*)(THQ + o_); ld[4 + i_] = *(const v4u*)(THI + o_); } } while (0)
    if (bid < NU) HP_LOAD(bid);
#pragma unroll 1
    for (int u = bid; u < NU; u += G) {
        const int h = u & 3; const size_t row0 = (size_t)(u >> 2) * 64;
#pragma unroll
        for (int i = 0; i < 2; ++i) { const int p = tid + NTHREADS * i, o = (p >> 4) * HPRP + (p & 15) * 16;
            *(LAS v4u*)(lds + HPO_LF + o) = ld[i]; *(LAS v4u*)(lds + HPO_Q + o) = ld[2 + i]; *(LAS v4u*)(lds + HPO_I + o) = ld[4 + i]; }
        __syncthreads();
        if (u + G < NU) HP_LOAD(u + G);
        float lf[16], qv[16], iv[16], gl[16];
#pragma unroll
        for (int i = 0; i < 16; ++i) { const int o = (sa * 16 + i) * HPRP + d * 2;
            lf[i] = bf2f(*(const LAS unsigned short*)(lds + HPO_LF + o)); qv[i] = bf2f(*(const LAS unsigned short*)(lds + HPO_Q + o)); iv[i] = bf2f(*(const LAS unsigned short*)(lds + HPO_I + o)); }
        { float g = 0.f;
#pragma unroll
          for (int i = 0; i < 16; ++i) { g += lf[i]; gl[i] = g; } }
        sTot[sa * 128 + d] = gl[15];
        __syncthreads();
        const float t0 = sTot[d], t1 = sTot[128 + d], t2 = sTot[256 + d], t3 = sTot[384 + d];
        const float pre = (sa > 0 ? t0 : 0.f) + (sa > 1 ? t1 : 0.f) + (sa > 2 ? t2 : 0.f);
        const float tsa = sa == 0 ? t0 : sa == 1 ? t1 : sa == 2 ? t2 : t3;
        const float glast = (t0 + t1) + (t2 + t3);
        const float cpre = __expf(pre);
        const float cr1 = __expf(sa == 2 ? t1 : t1 + t2);
        const float cr2 = __expf(t2);
        const float ctail = __expf(glast - (pre + tsa));
        float kt[16];
#pragma unroll
        for (int i = 0; i < 16; ++i) { const int t = sa * 16 + i, o = t * HPRP + d * 2; const float gi = gl[i];
            const float E = __expf(gi), Dc = __expf(fminf(-gi, 80.f)), Kb = __expf(tsa - gi), kk = 1.0f - __expf(lf[i]);
            const float qd = qv[i] * E;
            *(LAS unsigned short*)(lds + HPO_QD + o) = (unsigned short)f2bf(qd);
            if (sa == 2) *(LAS unsigned short*)(lds + HPO_QX + i * HPRP + d * 2) = (unsigned short)f2bf(qd * cr1);
            if (sa == 3) { *(LAS unsigned short*)(lds + HPO_QX + (16 + i) * HPRP + d * 2) = (unsigned short)f2bf(qd * cr1); *(LAS unsigned short*)(lds + HPO_QX + (32 + i) * HPRP + d * 2) = (unsigned short)f2bf(qd * cr2); }
            *(LAS unsigned short*)(lds + HPO_Q + o) = (unsigned short)f2bf(qd * cpre);
            *(LAS unsigned short*)(lds + HPO_KD + o) = (unsigned short)f2bf(kk * Dc);
            const float kb = kk * Kb;
            if (sa < 3) *(LAS unsigned short*)(lds + HPO_KB + o) = (unsigned short)f2bf(kb);
            kt[i] = kb * ctail; }
        {
            const size_t toff = (row0 + (d >> 1)) * 512 + h * 128 + (d & 1) * 64 + sa * 16;
            *(v4u*)(THF + toff) = pack8((f32x4){kt[0], kt[1], kt[2], kt[3]}, (f32x4){kt[4], kt[5], kt[6], kt[7]});
            *(v4u*)(THF + toff + 8) = pack8((f32x4){kt[8], kt[9], kt[10], kt[11]}, (f32x4){kt[12], kt[13], kt[14], kt[15]});
            *(v4u*)(THI + toff) = pack8((f32x4){iv[0], iv[1], iv[2], iv[3]}, (f32x4){iv[4], iv[5], iv[6], iv[7]});
            *(v4u*)(THI + toff + 8) = pack8((f32x4){iv[8], iv[9], iv[10], iv[11]}, (f32x4){iv[12], iv[13], iv[14], iv[15]}); }
        if (sa == 3) HDEC[(size_t)u * 128 + d] = __expf(glast);
        __syncthreads();
        bf16* at = HATTN + (size_t)u * 4096;
        for (int blk = wave; blk < 10; blk += 8) {
            const int ba = blk >= 6 ? 3 : blk >= 3 ? 2 : blk >= 1 ? 1 : 0, bb = blk - (ba * (ba + 1)) / 2;
            const int arow = (bb + 1 >= ba) ? HPO_QD + (16 * ba) * HPRP : HPO_QX + (ba == 2 ? 0 : 16 * (1 + bb)) * HPRP;
            const int brow = (bb == ba) ? HPO_KD + (16 * ba) * HPRP : HPO_KB + (16 * bb) * HPRP;
            f32x4 c = (f32x4){0.f, 0.f, 0.f, 0.f};
#pragma unroll
            for (int ks = 0; ks < 4; ++ks) { const bf16x8 A = *(const LAS bf16x8*)(lds + arow + fr * HPRP + (32 * ks + 8 * fq) * 2), B = *(const LAS bf16x8*)(lds + brow + fr * HPRP + (32 * ks + 8 * fq) * 2);
                c = __builtin_amdgcn_mfma_f32_16x16x32_bf16(A, B, c, 0, 0, 0); }
#pragma unroll
            for (int r = 0; r < 4; ++r) { const int tl = 4 * fq + r; const float v = (bb < ba || fr <= tl) ? c[r] : 0.f; at[(ba * 16 + tl) * 64 + bb * 16 + fr] = (bf16)f2bf(v); }
        }
        for (int e = tid; e < 6 * 256; e += NTHREADS) { const int z = e >> 8, za = z < 3 ? 0 : (z < 5 ? 1 : 2), zb = z < 3 ? z + 1 : (z < 5 ? z - 1 : 3);
            at[(za * 16 + ((e >> 4) & 15)) * 64 + zb * 16 + (e & 15)] = (bf16)0; }
#pragma unroll
        for (int i = 0; i < 2; ++i) { const int p = tid + NTHREADS * i; *(v4u*)(THQ + (row0 + (p >> 4)) * 512 + h * 128 + (p & 15) * 8) = *(const LAS v4u*)(lds + HPO_Q + (p >> 4) * HPRP + (p & 15) * 16); }
        __syncthreads();
    }
#undef HP_LOAD
}

__device__ __forceinline__ void phase_conv(ArgsP a, int l, int G, int bid, int wv) {
    unsigned char* ws = a->ws;
    bf16* TCB = (bf16*)(ws + A_TCB); const bf16* TU = (const bf16*)(ws + A_TU);
    const float* cw = a->in[8] + (size_t)l * 3 * 512;
    const int tid = opaque_tid(wv);
    const int c0 = (tid & 63) * 8;
    float w0[8], w1[8], w2[8];
#pragma unroll
    for (int j = 0; j < 8; ++j) { w0[j] = cw[c0 + j]; w1[j] = cw[512 + c0 + j]; w2[j] = cw[1024 + c0 + j]; }
    const int rstep = G * (NTHREADS / 64);
    v4u q2a[4], q1a[4], q0a[4], qba[4], q2b[4], q1b[4], q0b[4], qbb[4];
#define CONV_LOAD(q2_, q1_, q0_, qb_, r0_) do { _Pragma("unroll") for (int i = 0; i < 4; ++i) { const int row = (r0_) + i * rstep; const int t = row & (SEQ - 1); \
            if (row < MTOK) { const bf16* up = TU + (size_t)row * 512 + c0; \
                q2_[i] = *(const v4u*)up; qb_[i] = *(const v4u*)(TCB + (size_t)row * 512 + c0); \
                q1_[i] = (t >= 1) ? *(const v4u*)(up - 512) : (v4u){0u, 0u, 0u, 0u}; \
                q0_[i] = (t >= 2) ? *(const v4u*)(up - 1024) : (v4u){0u, 0u, 0u, 0u}; } } } while (0)
#define CONV_DO(q2_, q1_, q0_, qb_, r0_) do { _Pragma("unroll") for (int i = 0; i < 4; ++i) { const int row = (r0_) + i * rstep; \
            if (row < MTOK) { float u0[8], u1[8], u2[8], cb[8]; \
                unpack8(q2_[i], u2); unpack8(q1_[i], u1); unpack8(q0_[i], u0); unpack8(qb_[i], cb); \
                f32x4 ra, rb; \
                _Pragma("unroll") for (int j = 0; j < 8; ++j) { const float y = cb[j] * (w0[j] * u0[j] + w1[j] * u1[j] + w2[j] * u2[j]); if (j < 4) ra[j] = y; else rb[j - 4] = y; } \
                *(v4u*)(TCB + (size_t)row * 512 + c0) = pack8(ra, rb); } } } while (0)
    int r0 = bid * (NTHREADS / 64) + (tid >> 6);
    CONV_LOAD(q2a, q1a, q0a, qba, r0);
#pragma unroll 1
    for (; r0 < MTOK; r0 += 8 * rstep) {
        CONV_LOAD(q2b, q1b, q0b, qbb, r0 + 4 * rstep);
        CONV_DO(q2a, q1a, q0a, qba, r0);
        CONV_LOAD(q2a, q1a, q0a, qba, r0 + 8 * rstep);
        CONV_DO(q2b, q1b, q0b, qbb, r0 + 4 * rstep);
    }
#undef CONV_LOAD
#undef CONV_DO
}

__device__ __forceinline__ void hgrn_post_bh(const bf16* HO, bf16* THG, const float* gn, int b, int h, int tid) {
    const int lane = tid & 63, wave = tid >> 6, c8 = (lane & 15) * 8;
    float gv[8];
#pragma unroll
    for (int j = 0; j < 8; ++j) gv[j] = gn[c8 + j];
#pragma unroll 1
    for (int t0 = wave * 4 + (lane >> 4); t0 < SEQ; t0 += NWAVES * 4 * 8) {
        v4u ov[8], hv[8];
#pragma unroll
        for (int i = 0; i < 8; ++i) { const size_t off = ((size_t)b * SEQ + t0 + i * NWAVES * 4) * 512 + h * 128 + c8; ov[i] = *(const v4u*)(HO + off); hv[i] = *(const v4u*)(THG + off); }
#pragma unroll
        for (int i = 0; i < 8; ++i) { const size_t off = ((size_t)b * SEQ + t0 + i * NWAVES * 4) * 512 + h * 128 + c8;
            float o[8], hg[8];
            unpack8(ov[i], o); unpack8(hv[i], hg);
            float ss = 0.f;
#pragma unroll
            for (int j = 0; j < 8; ++j) ss += o[j] * o[j];
            ss += shx(ss, 1, lane); ss += shx(ss, 2, lane); ss += shx(ss, 4, lane); ss += shx(ss, 8, lane);
            const float r = rsqrtf(ss * (1.0f / 128.0f) + EPS);
            f32x4 r0, r1;
#pragma unroll
            for (int j = 0; j < 8; ++j) { const float y = o[j] * r * gv[j] * (hg[j] * sigmoidf_(hg[j])); if (j < 4) r0[j] = y; else r1[j - 4] = y; }
            *(v4u*)(THG + off) = pack8(r0, r1); }
    }
}
constexpr int HS_ATT = 0, HS_Q = 9216, HS_K = 26624, HS_DEC = 45056, HS_BUF = 45568;
__device__ __forceinline__ void phase_hgrn_seq(ArgsP a, LAS unsigned char* lds, int l, int G, int bid, int wv) {
    unsigned char* ws = a->ws;
    const bf16* THQ = (const bf16*)(ws + A_THQ); const bf16* THF = (const bf16*)(ws + A_THF); const bf16* THI = (const bf16*)(ws + A_THI);
    const bf16* HATTN = (const bf16*)(ws + A_HATTN); const float* HDEC = (const float*)(ws + A_HDEC); bf16* HO = (bf16*)(ws + A_HO);
    const int tid = opaque_tid(wv), lane = tid & 63, wave = __builtin_amdgcn_readfirstlane(tid >> 6), fr = lane & 15, fq = lane >> 4;
    constexpr int NCH = SEQ / 64;
    for (int u = bid; u < NBATCH * 4; u += G) {
        const int h = u & 3, b = u >> 2;
        const int vcol = 16 * wave + fr;
        f32x4 Sacc[8]; bf16x8 Sb[4];
#pragma unroll
        for (int i = 0; i < 8; ++i) Sacc[i] = (f32x4){0.f, 0.f, 0.f, 0.f};
#pragma unroll
        for (int i = 0; i < 4; ++i) Sb[i] = (bf16x8){0, 0, 0, 0, 0, 0, 0, 0};
        v4u st[5]; float stdec = 0.f; bf16x8 bi[2], bin[2];
#define HS_LOAD(c_) do { const size_t row0_ = (size_t)b * SEQ + (size_t)(c_) * 64; const size_t cu_ = ((size_t)b * NCH + (c_)) * 4 + h; \
            st[0] = *(const v4u*)(HATTN + cu_ * 4096 + (size_t)tid * 8); \
            _Pragma("unroll") for (int i_ = 0; i_ < 2; ++i_) { const int p_ = tid + 512 * i_; \
                st[1 + i_] = *(const v4u*)(THQ + (row0_ + (p_ >> 4)) * 512 + h * 128 + (p_ & 15) * 8); \
                const int d_ = p_ >> 3; st[3 + i_] = *(const v4u*)(THF + (row0_ + (d_ >> 1)) * 512 + h * 128 + (d_ & 1) * 64 + (p_ & 7) * 8); } \
            if (tid < 128) stdec = HDEC[cu_ * 128 + tid]; } while (0)
#define HS_WRITE(buf_) do { LAS unsigned char* q_ = lds + (buf_) * HS_BUF; \
            *(LAS v4u*)(q_ + HS_ATT + (tid >> 3) * 144 + (tid & 7) * 16) = st[0]; \
            _Pragma("unroll") for (int i_ = 0; i_ < 2; ++i_) { const int p_ = tid + 512 * i_; \
                *(LAS v4u*)(q_ + HS_Q + (p_ >> 4) * 272 + (p_ & 15) * 16) = st[1 + i_]; \
                *(LAS v4u*)(q_ + HS_K + (p_ >> 3) * 144 + (p_ & 7) * 16) = st[3 + i_]; } \
            if (tid < 128) *(LAS float*)(q_ + HS_DEC + tid * 4) = stdec; } while (0)
#define HS_LOADI(dst_, c_) do { const size_t row0_ = (size_t)b * SEQ + (size_t)(c_) * 64; \
            _Pragma("unroll") for (int ks_ = 0; ks_ < 2; ++ks_) dst_[ks_] = *(const bf16x8*)(THI + (row0_ + (vcol >> 1)) * 512 + h * 128 + (vcol & 1) * 64 + 32 * ks_ + 8 * fq); } while (0)
        __syncthreads();
        HS_LOAD(0); HS_LOADI(bin, 0);
        HS_WRITE(0);
        __syncthreads();
        HS_LOAD(1);
#pragma unroll 1
        for (int c = 0; c < NCH; ++c) {
            bi[0] = bin[0]; bi[1] = bin[1];
            if (c + 1 < NCH) HS_LOADI(bin, c + 1);
            const LAS unsigned char* buf = lds + (c & 1) * HS_BUF;
            const size_t row0 = (size_t)b * SEQ + (size_t)c * 64;
#pragma unroll
            for (int rt = 0; rt < 4; ++rt) {
                f32x4 acc = (f32x4){0.f, 0.f, 0.f, 0.f};
#pragma unroll
                for (int ks = 0; ks < 2; ++ks) { const bf16x8 A = *(const LAS bf16x8*)(buf + HS_ATT + (16 * rt + fr) * 144 + (32 * ks + 8 * fq) * 2);
                    acc = __builtin_amdgcn_mfma_f32_16x16x32_bf16(A, bi[ks], acc, 0, 0, 0); }
#pragma unroll
                for (int ks = 0; ks < 4; ++ks) { const v2u lo = *(const LAS v2u*)(buf + HS_Q + (16 * rt + fr) * 272 + (32 * ks + 4 * fq) * 2), hi = *(const LAS v2u*)(buf + HS_Q + (16 * rt + fr) * 272 + (32 * ks + 16 + 4 * fq) * 2);
                    const v4u t4 = (v4u){lo.x, lo.y, hi.x, hi.y};
                    acc = __builtin_amdgcn_mfma_f32_16x16x32_bf16(__builtin_bit_cast(bf16x8, t4), Sb[ks], acc, 0, 0, 0); }
#pragma unroll
                for (int r = 0; r < 4; ++r) HO[(row0 + 16 * rt + 4 * fq + r) * 512 + h * 128 + vcol] = (bf16)f2bf(acc[r]);
            }
#pragma unroll
            for (int dt = 0; dt < 8; ++dt) {
                const f32x4 dec4 = *(const LAS f32x4*)(buf + HS_DEC + (16 * dt + 4 * fq) * 4);
                Sacc[dt] = Sacc[dt] * dec4;
#pragma unroll
                for (int ks = 0; ks < 2; ++ks) { const bf16x8 A = *(const LAS bf16x8*)(buf + HS_K + (16 * dt + fr) * 144 + (32 * ks + 8 * fq) * 2);
                    Sacc[dt] = __builtin_amdgcn_mfma_f32_16x16x32_bf16(A, bi[ks], Sacc[dt], 0, 0, 0); }
            }
#pragma unroll
            for (int ks = 0; ks < 4; ++ks) { const v4u t4 = (v4u){pk2(Sacc[2 * ks][0], Sacc[2 * ks][1]), pk2(Sacc[2 * ks][2], Sacc[2 * ks][3]), pk2(Sacc[2 * ks + 1][0], Sacc[2 * ks + 1][1]), pk2(Sacc[2 * ks + 1][2], Sacc[2 * ks + 1][3])};
                Sb[ks] = __builtin_bit_cast(bf16x8, t4); }
            if (c + 1 < NCH) { HS_WRITE((c + 1) & 1); if (c + 2 < NCH) HS_LOAD(c + 2); }
            __syncthreads();
        }
#undef HS_LOAD
#undef HS_WRITE
#undef HS_LOADI
        asm volatile("s_waitcnt vmcnt(0)" ::: "memory");
        __syncthreads();
        hgrn_post_bh(HO, (bf16*)(ws + A_THG), a->in[7] + l * 128, b, h, tid);
    }
}

typedef float f32x2q __attribute__((ext_vector_type(2)));
typedef __bf16 bf16x2n __attribute__((ext_vector_type(2)));
__device__ __forceinline__ v4u fp8x8_to_bf16(unsigned u0, unsigned u1) {
    return (v4u){__builtin_bit_cast(unsigned, __builtin_amdgcn_cvt_scalef32_pk_bf16_fp8(u0, 1.0f, false)), __builtin_bit_cast(unsigned, __builtin_amdgcn_cvt_scalef32_pk_bf16_fp8(u0, 1.0f, true)),
                 __builtin_bit_cast(unsigned, __builtin_amdgcn_cvt_scalef32_pk_bf16_fp8(u1, 1.0f, false)), __builtin_bit_cast(unsigned, __builtin_amdgcn_cvt_scalef32_pk_bf16_fp8(u1, 1.0f, true))};
}
__device__ __forceinline__ v2u tr_read(unsigned addr) { v2u r; asm volatile("ds_read_b64_tr_b16 %0, %1" : "=&v"(r) : "v"(addr) : "memory"); return r; }
__device__ __forceinline__ int vimg_off(int row, int ch) { return 256 * row + 16 * (ch ^ (((row & 3) << 2) | ((row >> 2) & 3))); }
constexpr int AT_WAVE = 16896, AT_IDX = 16384;
__device__ __forceinline__ void phase_attention(ArgsP a, LAS unsigned char* lds, int l, int G, int bid, int wv) {
    unsigned char* ws = a->ws;
    bf16* TQ = (bf16*)(ws + A_TQ); bf16* TOUT = TQ; const unsigned char* TKV8 = (const unsigned char*)(ws + A_TKV);     const unsigned short* SEL = (const unsigned short*)(ws + A_SEL);
    const int tid = opaque_tid(wv), lane = tid & 63, wave = __builtin_amdgcn_readfirstlane(tid >> 6), fr = lane & 15, fq = lane >> 4;
    LAS unsigned char* vimg = lds + wave * AT_WAVE;
    LAS unsigned short* idxs = (LAS unsigned short*)(vimg + AT_IDX);
    const unsigned vimg_a = (unsigned)(unsigned long)vimg;
    bf16x8 bb;
    {   float f[8];
#pragma unroll
        for (int jj = 0; jj < 8; ++jj) f[jj] = (fr < 8) ? a->in[1][(8 * fq + jj) * 8 + fr] : 0.f;
        const v4u w = pack8((f32x4){f[0], f[1], f[2], f[3]}, (f32x4){f[4], f[5], f[6], f[7]}); bb = __builtin_bit_cast(bf16x8, w); }
    __syncthreads();
    const int b = bid & 7;
    unsigned* ticket = (unsigned*)(ws + WS_CTL) + CW_TICKET + (l * 8 + b) * 64;
    int tnext = 0;
    constexpr int AT_BIG = (SEQ / 8 * 7) / 4;
#define AT_TICKET_Q(c_) ((c_) < AT_BIG ? 4 * (c_) : 4 * AT_BIG + ((c_) - AT_BIG))
    if (lane == 0) { const int c = (int)__hip_atomic_fetch_add(ticket, 1u, __ATOMIC_RELAXED, __HIP_MEMORY_SCOPE_AGENT); tnext = AT_TICKET_Q(c); }
    const unsigned char* kvb = TKV8 + (size_t)b * SEQ * 256;
    const int tq = fr >> 2, tp = fr & 3;
    v2u idxnext = (v2u){0u, 0u};
    v4u pend = (v4u){0u, 0u, 0u, 0u}; int prow = -1;
    {   const int t0 = __builtin_amdgcn_readfirstlane(tnext);
        if (t0 < SEQ) idxnext = *(const v2u*)((const unsigned char*)(SEL + ((size_t)b * SEQ + t0) * 256) + (unsigned)lane * 8u); }
#pragma unroll 1
    for (;;) {
        const int t = __builtin_amdgcn_readfirstlane(tnext);
        if (t >= SEQ) break;
        if ((t & 3) == 3 || t >= 4 * AT_BIG) { if (lane == 0) { const int c = (int)__hip_atomic_fetch_add(ticket, 1u, __ATOMIC_RELAXED, __HIP_MEMORY_SCOPE_AGENT); tnext = AT_TICKET_Q(c); } } else tnext = t + 1;
        const size_t row = (size_t)b * SEQ + t;
        const int n = t + 1 < 256 ? t + 1 : 256;
        *(LAS v2u*)(idxs + lane * 4) = idxnext;
        bf16x8 bq[4];
        {   v4u w0 = (v4u){0u, 0u, 0u, 0u}, w1 = w0;
            if (fr < 8) { float f[8], g8[8]; const bf16* qp = TQ + row * 512 + fr * 64 + 16 * fq;
                unpack8(*(const v4u*)qp, f); unpack8(*(const v4u*)(qp + 8), g8);
                w0 = pack8((f32x4){f[0] * 0.125f, f[1] * 0.125f, f[2] * 0.125f, f[3] * 0.125f}, (f32x4){f[4] * 0.125f, f[5] * 0.125f, f[6] * 0.125f, f[7] * 0.125f});
                w1 = pack8((f32x4){g8[0] * 0.125f, g8[1] * 0.125f, g8[2] * 0.125f, g8[3] * 0.125f}, (f32x4){g8[4] * 0.125f, g8[5] * 0.125f, g8[6] * 0.125f, g8[7] * 0.125f}); }
            const v4u z = (v4u){0u, 0u, 0u, 0u}; const bool g1 = (fr >> 2) == 1;
            bq[0] = __builtin_bit_cast(bf16x8, g1 ? z : w0); bq[1] = __builtin_bit_cast(bf16x8, g1 ? z : w1);
            bq[2] = __builtin_bit_cast(bf16x8, g1 ? w0 : z); bq[3] = __builtin_bit_cast(bf16x8, g1 ? w1 : z); }
        LDS_WAIT();
        f32x4 acc[16]; v4u KA[16][2]; int kix[16];
#define AT_KLOAD(tile_) do { const int slot_ = (tile_) * 16 + fr; kix[tile_] = (int)idxs[slot_]; const unsigned char* kp_ = kvb + (size_t)kix[tile_] * 256 + 16 * fq; \
            KA[tile_][0] = *(const v4u*)kp_; KA[tile_][1] = *(const v4u*)(kp_ + 64); } while (0)
        AT_KLOAD(0); AT_KLOAD(1); AT_KLOAD(2);
        asm volatile("" ::: "memory");
#pragma unroll
        for (int tile = 0; tile < 16; ++tile) {
            if (tile + 3 < 16) { AT_KLOAD(tile + 3); asm volatile("" ::: "memory"); }
            const int dist = t - kix[tile];
            int bu = dist;
            if (dist >= 16) { bu = 16 + (int)((__log2f((float)dist) - 4.0f) * (16.0f / 3.0f)); bu = bu > 31 ? 31 : bu; }
            const unsigned mhot = ((bu >> 3) == fq) ? (0x3F80u << ((bu & 1) * 16)) : 0u; const int wsel = (bu >> 1) & 3;
            const v4u oh = (v4u){wsel == 0 ? mhot : 0u, wsel == 1 ? mhot : 0u, wsel == 2 ? mhot : 0u, wsel == 3 ? mhot : 0u};
            f32x4 c;
#pragma unroll
            for (int g = 0; g < 2; ++g) { const v4u kw = KA[tile][g];
                c = __builtin_amdgcn_mfma_f32_16x16x32_bf16(__builtin_bit_cast(bf16x8, fp8x8_to_bf16(kw.x, kw.y)), bq[2 * g], g == 0 ? (f32x4){0.f, 0.f, 0.f, 0.f} : c, 0, 0, 0);
                c = __builtin_amdgcn_mfma_f32_16x16x32_bf16(__builtin_bit_cast(bf16x8, fp8x8_to_bf16(kw.z, kw.w)), bq[2 * g + 1], c, 0, 0, 0); }
            acc[tile] = __builtin_amdgcn_mfma_f32_16x16x32_bf16(__builtin_bit_cast(bf16x8, oh), bb, c, 0, 0, 0);
        }
#undef AT_KLOAD
        if (prow >= 0) *(v4u*)(TOUT + (size_t)prow * 512 + lane * 8) = pend;
        v4u VS[8][4];
#define AT_VLOAD(hc_) do { _Pragma("unroll") for (int i_ = 0; i_ < 4; ++i_) { const int p_ = lane + 64 * i_; const int slot_ = 32 * (hc_) + (p_ >> 3); const int kidx_ = (int)idxs[slot_]; \
            VS[hc_][i_] = *(const v4u*)(kvb + (size_t)kidx_ * 256 + 128 + 16 * (p_ & 7)); } } while (0)
        AT_VLOAD(0);
        {   const int tn = __builtin_amdgcn_readfirstlane(tnext); unsigned lo8 = (unsigned)lane * 8u; asm volatile("" : "+v"(lo8));
            if (tn < SEQ) idxnext = *(const v2u*)((const unsigned char*)(SEL + ((size_t)b * SEQ + tn) * 256) + lo8); }
        asm volatile("" ::: "memory");
        if (n < 256) {
#pragma unroll
            for (int tile = 0; tile < 16; ++tile)
#pragma unroll
                for (int r = 0; r < 4; ++r) if (tile * 16 + 4 * fq + r >= n) acc[tile][r] = -INFINITY;
        }
        float mx = -INFINITY;
#pragma unroll
        for (int tile = 0; tile < 16; ++tile) mx = fmaxf(mx, fmaxf(fmaxf(acc[tile][0], acc[tile][1]), fmaxf(acc[tile][2], acc[tile][3])));
        mx = fmaxf(mx, shx(mx, 16, lane)); mx = fmaxf(mx, shx(mx, 32, lane));
        float sum = 0.f;
#pragma unroll
        for (int tile = 0; tile < 16; ++tile)
#pragma unroll
            for (int r = 0; r < 4; ++r) { const float e = __expf(acc[tile][r] - mx); acc[tile][r] = e; sum += e; }
        sum += shx(sum, 16, lane); sum += shx(sum, 32, lane);
        const float inv = __builtin_amdgcn_rcpf(sum);
        bf16x8 Pa[8];
#pragma unroll
        for (int k2 = 0; k2 < 8; ++k2) { const v4u w = pack8(acc[2 * k2] * inv, acc[2 * k2 + 1] * inv); Pa[k2] = __builtin_bit_cast(bf16x8, w); }
        f32x4 o[2][4];
#pragma unroll
        for (int hc = 0; hc < 8; ++hc) {
            if (hc + 1 < 8) { AT_VLOAD(hc + 1); asm volatile("" ::: "memory"); }
            const int rb = 32 * (hc & 1);
#pragma unroll
            for (int i = 0; i < 4; ++i) { const int p = lane + 64 * i, rowl = rb + (p >> 3), c16 = p & 7;
                *(LAS v4u*)(vimg + vimg_off(rowl, 2 * c16)) = fp8x8_to_bf16(VS[hc][i].x, VS[hc][i].y);
                *(LAS v4u*)(vimg + vimg_off(rowl, 2 * c16 + 1)) = fp8x8_to_bf16(VS[hc][i].z, VS[hc][i].w); }
            LDS_WAIT();
#pragma unroll
            for (int g = 0; g < 2; ++g) {
                v2u lo[4], hi[4];
#pragma unroll
                for (int dt = 0; dt < 4; ++dt) { const int ch = 8 * g + 2 * dt + (tp >> 1), r0 = rb + 4 * fq + tq;
                    lo[dt] = tr_read(vimg_a + vimg_off(r0, ch) + 8 * (tp & 1)); hi[dt] = tr_read(vimg_a + vimg_off(r0 + 16, ch) + 8 * (tp & 1)); }
                asm volatile("s_waitcnt lgkmcnt(0)" : "+v"(lo[0]), "+v"(lo[1]), "+v"(lo[2]), "+v"(lo[3]), "+v"(hi[0]), "+v"(hi[1]), "+v"(hi[2]), "+v"(hi[3]) :: "memory");
#pragma unroll
                for (int dt = 0; dt < 4; ++dt) { const v4u w = (v4u){lo[dt].x, lo[dt].y, hi[dt].x, hi[dt].y};
                    o[g][dt] = __builtin_amdgcn_mfma_f32_16x16x32_bf16(Pa[hc], __builtin_bit_cast(bf16x8, w), hc == 0 ? (f32x4){0.f, 0.f, 0.f, 0.f} : o[g][dt], 0, 0, 0); }
            }
        }
#undef AT_VLOAD
        if (fq < 2) {
#pragma unroll
            for (int g = 0; g < 2; ++g) if (g == fq) {
#pragma unroll
                for (int dt = 0; dt < 4; ++dt)
#pragma unroll
                    for (int r = 0; r < 4; ++r) *(LAS unsigned short*)(vimg + ((4 * g + r) * 64 + dt * 16 + fr) * 2) = (unsigned short)f2bf(o[g][dt][r]); }
        }
        LDS_WAIT();
        pend = *(const LAS v4u*)(vimg + lane * 16); prow = (int)row;
        LDS_WAIT();
    }
    if (prow >= 0) *(v4u*)(TOUT + (size_t)prow * 512 + lane * 8) = pend;
}
#ifndef ONE_LAUNCH
#define ONE_LAUNCH 1
#endif
constexpr int NPH_LAYER = 8, NPHASE = 1 + NLAYER * NPH_LAYER;

__global__ void __launch_bounds__(NTHREADS, 2) fwd_kernel(Args args_unused) {
    extern __shared__ __attribute__((aligned(16))) unsigned char lds_raw[];
    LAS unsigned char* lds = (LAS unsigned char*)lds_raw;
    volatile LAS unsigned* misc = (volatile LAS unsigned*)(lds + MISC_OFF);
    if (threadIdx.x < 64) misc[threadIdx.x] = 0u;
    const int wv = __builtin_amdgcn_readfirstlane((int)threadIdx.x >> 6);
    __syncthreads();
    if (get_args()->ph_hi - get_args()->ph_lo > 1) (void)xcd_barrier_post((unsigned*)(get_args()->ws + WS_CTL) + CW_BAR, misc + 8);
#define PH_LO (get_args()->ph_lo)
#define PH_HI (get_args()->ph_hi)
#define IN(k) (PH_LO <= (k) && (k) < PH_HI)
#define SEAM(k) do { if ((k) + 1 < PH_HI) { XcdBarrier b_; b_.bar = (unsigned*)(get_args()->ws + WS_CTL) + CW_BAR; b_.x = xb_xcc_id(); b_.st = misc + 8; xcd_barrier(b_, opaque_tid(wv)); } } while (0)
#define GRID ((int)gridDim.x)
#define BID ((int)blockIdx.x)

    if (IN(0)) { phase_prologue(get_args(), lds, GRID, BID, wv); SEAM(0); }

#pragma unroll 1
    for (int l = 0; l < NLAYER; ++l) {
        const int p0 = 1 + l * NPH_LAYER;
#define WSP (get_args()->ws)
        if (IN(p0 + 0)) {
            ArgsP a = get_args(); unsigned char* ws = a->ws;
            pg8::Gemm g{(const bf16*)(ws + WS_XB), (const bf16*)(ws + WS_W + (size_t)l * W_LAYER + W_IN), MTOK, NINP, 1024}; pg8::StaticOrder S; S.init(MTOK, NINP, GRID, BID);
            pg8::EpiInProj E{(const u64*)(ws + WS_SSQ) + (size_t)(2 * l) * MTOK, (bf16*)(ws + A_TQ), (bf16*)(ws + A_TKV), (bf16*)(ws + A_TIQ), (bf16*)(ws + A_TIK), (float*)(ws + A_TIW),
                             (bf16*)(ws + A_THQ), (bf16*)(ws + A_THF), (bf16*)(ws + A_THI), (bf16*)(ws + A_THG), (bf16*)(ws + A_TCB), (bf16*)(ws + A_TU),
                             a->in[5] + l * 64, a->in[6] + l * 64, (const float*)(ws + WS_LB) + l * 512};
            pg8::gemm_phase<pg8::EpiInProj, pg8::StaticOrder, true, true>(lds, g, S, E, opaque_tid(wv));
            SEAM(p0 + 0);
        }
        if (IN(p0 + 1)) {
            phase_indexer(get_args(), lds, l, GRID, BID, wv);
            phase_hgrn_pre(get_args(), lds, GRID, BID, wv);
            phase_conv(get_args(), l, GRID, BID, wv);
            SEAM(p0 + 1);
        }
        if (IN(p0 + 2)) {
            phase_hgrn_seq(get_args(), lds, l, GRID, BID, wv);
            __syncthreads();
            phase_attention(get_args(), lds, l, GRID, BID, wv);
            SEAM(p0 + 2);
        }
        if (IN(p0 + 4)) {
            {   unsigned char* ws = WSP; pg8::StaticOrder S; S.init(MTOK, 1024, GRID, BID); pg8::EpiStoreBf16 EY{(bf16*)(ws + A_YB), 1024};
                pg8::Gemm g{(const bf16*)(ws + A_TQ), (const bf16*)(ws + WS_W + (size_t)l * W_LAYER + W_UA), MTOK, 1024, 512}; pg8::gemm_phase<pg8::EpiStoreBf16, pg8::StaticOrder, true, true>(lds, g, S, EY, opaque_tid(wv)); }
            {   unsigned char* ws = WSP; pg8::StaticOrder S; S.init(MTOK, 1024, GRID, BID); pg8::EpiGate<true> E{(const u64*)(ws + WS_SSQ) + (size_t)(2 * l) * MTOK, (const bf16*)(ws + A_YB), (bf16*)(ws + A_MIXED)};
                pg8::Gemm g{(const bf16*)(ws + WS_XB), (const bf16*)(ws + WS_W + (size_t)l * W_LAYER + W_G), MTOK, 1024, 1024}; pg8::gemm_phase<pg8::EpiGate<true>, pg8::StaticOrder, true, true>(lds, g, S, E, opaque_tid(wv)); }
            {   unsigned char* ws = WSP; pg8::StaticOrder S; S.init(MTOK, 1024, GRID, BID); pg8::EpiStoreBf16 EY{(bf16*)(ws + A_YB), 1024};
                pg8::Gemm g{(const bf16*)(ws + A_THG), (const bf16*)(ws + WS_W + (size_t)l * W_LAYER + W_UH), MTOK, 1024, 512}; pg8::gemm_phase<pg8::EpiStoreBf16, pg8::StaticOrder, true, true>(lds, g, S, EY, opaque_tid(wv)); }
            {   unsigned char* ws = WSP; pg8::StaticOrder S; S.init(MTOK, 1024, GRID, BID); pg8::EpiGate<false> E{(const u64*)(ws + WS_SSQ) + (size_t)(2 * l) * MTOK, (const bf16*)(ws + A_YB), (bf16*)(ws + A_MIXED)};
                pg8::Gemm g{(const bf16*)(ws + WS_XB), (const bf16*)(ws + WS_W + (size_t)l * W_LAYER + W_G + 2 * MiB), MTOK, 1024, 1024}; pg8::gemm_phase<pg8::EpiGate<false>, pg8::StaticOrder, true, true>(lds, g, S, E, opaque_tid(wv)); }
            {   unsigned char* ws = WSP; pg8::StaticOrder S; S.init(MTOK, 1024, GRID, BID); pg8::EpiStoreBf16 EY{(bf16*)(ws + A_YB), 1024};
                pg8::Gemm g{(const bf16*)(ws + A_TCB), (const bf16*)(ws + WS_W + (size_t)l * W_LAYER + W_UC), MTOK, 1024, 512}; pg8::gemm_phase<pg8::EpiStoreBf16, pg8::StaticOrder, true, true>(lds, g, S, EY, opaque_tid(wv)); }
            {   unsigned char* ws = WSP; pg8::StaticOrder S; S.init(MTOK, 1024, GRID, BID); pg8::EpiGate<false> E{(const u64*)(ws + WS_SSQ) + (size_t)(2 * l) * MTOK, (const bf16*)(ws + A_YB), (bf16*)(ws + A_MIXED)};
                pg8::Gemm g{(const bf16*)(ws + WS_XB), (const bf16*)(ws + WS_W + (size_t)l * W_LAYER + W_G + 4 * MiB), MTOK, 1024, 1024}; pg8::gemm_phase<pg8::EpiGate<false>, pg8::StaticOrder, true, true>(lds, g, S, E, opaque_tid(wv)); }
            SEAM(p0 + 4);
        }
        if (IN(p0 + 5)) {
            ArgsP a = get_args(); unsigned char* ws = a->ws;
            pg8::Gemm g{(const bf16*)(ws + A_MIXED), (const bf16*)(ws + WS_W + (size_t)l * W_LAYER + W_O), MTOK, 1024, 1024}; pg8::StaticOrder S; S.init(MTOK, 1024, GRID, BID);
            pg8::EpiResidual E{(bf16*)(ws + WS_XB), (float*)nullptr, (u64*)(ws + WS_SSQ) + (size_t)(2 * l + 1) * MTOK, (const u64*)nullptr};
            pg8::gemm_phase<pg8::EpiResidual, pg8::StaticOrder, true, true>(lds, g, S, E, opaque_tid(wv));
            SEAM(p0 + 5);
        }
        if (IN(p0 + 6)) {
            unsigned char* ws = WSP;
            pg8::Gemm g{(const bf16*)(ws + WS_XB), (const bf16*)(ws + WS_W + (size_t)l * W_LAYER + W_UP), MTOK, DFF, 1024}; pg8::StaticOrder S; S.init(MTOK, DFF, GRID, BID);
            pg8::EpiMlpUp E{(bf16*)(ws + A_HIDDEN)};
            pg8::gemm_phase<pg8::EpiMlpUp, pg8::StaticOrder, true, true>(lds, g, S, E, opaque_tid(wv));
            SEAM(p0 + 6);
        }
        if (IN(p0 + 7)) {
            ArgsP a = get_args(); unsigned char* ws = a->ws;
            pg8::Gemm g{(const bf16*)(ws + A_HIDDEN), (const bf16*)(ws + WS_W + (size_t)l * W_LAYER + W_DN), MTOK, 1024, DFF}; pg8::StaticOrder S; S.init(MTOK, 1024, GRID, BID);
            pg8::EpiResidual E{(bf16*)(ws + WS_XB), (l + 1 < NLAYER) ? (float*)nullptr : a->out, (l + 1 < NLAYER) ? (u64*)(ws + WS_SSQ) + (size_t)(2 * l + 2) * MTOK : (u64*)nullptr, (const u64*)(ws + WS_SSQ) + (size_t)(2 * l + 1) * MTOK};
            pg8::gemm_phase<pg8::EpiResidual, pg8::StaticOrder, true, true>(lds, g, S, E, opaque_tid(wv));
            SEAM(p0 + 7);
        }
    }
#undef IN
#undef SEAM
}

extern "C" void kernel_launch(void* const* d_in, const int* in_sizes, int n_in, void* d_out, int out_size, void* d_ws, size_t ws_size, hipStream_t stream) {
    static int grid = 0;
    if (grid == 0) {
        if (n_in != 16 || in_sizes[0] != MTOK * DM || out_size != MTOK * DM || ws_size < WS_END) {
            fprintf(stderr, "kernel_launch: unexpected shapes / workspace (n_in %d, in0 %d, out %d, ws %zu, need %zu); nothing launched\n", n_in, n_in > 0 ? in_sizes[0] : -1, out_size, ws_size, (size_t)WS_END);
            grid = -1; return; }
        int dev = 0, cus = 0, per_cu = 0;
        if (hipGetDevice(&dev) != hipSuccess || hipDeviceGetAttribute(&cus, hipDeviceAttributeMultiprocessorCount, dev) != hipSuccess) { grid = -1; return; }
        if (hipFuncSetAttribute((const void*)fwd_kernel, hipFuncAttributeMaxDynamicSharedMemorySize, LDS_BYTES) != hipSuccess) { fprintf(stderr, "kernel_launch: hipFuncSetAttribute failed\n"); grid = -1; return; }
        if (hipOccupancyMaxActiveBlocksPerMultiprocessor(&per_cu, (const void*)fwd_kernel, NTHREADS, LDS_BYTES) != hipSuccess || per_cu < 1) fprintf(stderr, "kernel_launch: occupancy query reports %d\n", per_cu);
        (void)hipGetLastError();
        grid = cus < 256 ? cus : 256;
    }
    if (grid < 0) return;
    if (hipMemsetAsync((char*)d_ws + WS_CTL, 0, CTL_ZERO_BYTES, stream) != hipSuccess) { fprintf(stderr, "kernel_launch: memset failed\n"); return; }
    Args a{};
    for (int i = 0; i < 16; ++i) a.in[i] = (const float*)d_in[i];
    a.out = (float*)d_out; a.ws = (unsigned char*)d_ws;
#if ONE_LAUNCH
    a.ph_lo = 0; a.ph_hi = NPHASE;
    hipLaunchKernelGGL(fwd_kernel, dim3(grid), dim3(NTHREADS), LDS_BYTES, stream, a);
#else
    for (int p = 0; p < NPHASE; ++p) { a.ph_lo = p; a.ph_hi = p + 1; hipLaunchKernelGGL(fwd_kernel, dim3(grid), dim3(NTHREADS), LDS_BYTES, stream, a); }
#endif
    const hipError_t le = hipPeekAtLastError();
    if (le != hipSuccess) fprintf(stderr, "kernel_launch: launch failed: %s\n", hipGetErrorName(le));
}
```
